# Optimizing an MI355X kernel written in HIP

```python
import jax
import jax.numpy as jnp
from jax import lax
import numpy as np

D_MODEL = 1024
BATCH = 2
SEQ = 16384
DEPTH = 4

CTX_LEN = 256
GRID_W = 64
EPS = 1e-6
NEG_INF = -1e30
ROPE_BASE = 10000.0
CHUNK = 64

GLA_HEADS = 4
GLA_DK = 64
GLA_DV = 128
GLA_RANK = 16
GLA_TEMP = 16.0
LRU_WIDTH = 512
LRU_BLOCKS = 4
LRU_CONV = 4
LRU_C = 8.0
HEAD_DIM = 64
SWA_QH = 8
SWA_KVH = 2
WINDOW = 128
BLOCK = 128
RET_HEADS = 4
RET_DK = 64
RET_DV = 128

EVEN_SIZES = (GLA_HEADS * GLA_DK, GLA_HEADS * GLA_DK, GLA_HEADS * GLA_DV, GLA_HEADS * GLA_DV,
              2 * GLA_RANK, LRU_WIDTH, LRU_WIDTH)
ODD_SIZES = (SWA_QH * HEAD_DIM, SWA_KVH * HEAD_DIM, SWA_KVH * HEAD_DIM, SWA_QH * HEAD_DIM,
             RET_HEADS * RET_DK, RET_HEADS * RET_DK, RET_HEADS * RET_DV, RET_HEADS * RET_DV)
EVEN_IN = sum(EVEN_SIZES)
ODD_IN = sum(ODD_SIZES)
EVEN_MIX = GLA_HEADS * GLA_DV + LRU_WIDTH
ODD_MIX = SWA_QH * HEAD_DIM + RET_HEADS * RET_DV

kernel_name = "hybrid_gla_rglru_swa_retention_dit"


def rms_norm(x, g):
    xf = x.astype(jnp.float32)
    y = xf * lax.rsqrt(jnp.mean(xf * xf, axis=-1, keepdims=True) + EPS)
    return (y * g.astype(jnp.float32)).astype(x.dtype)


def head_rms_norm(o, g):
    B, L = o.shape[:2]
    return rms_norm(o, g).reshape(B, L, -1)


def split_cols(z, sizes):
    return jnp.split(z, np.cumsum(sizes)[:-1].tolist(), axis=-1)


def axial_rope_tables(row, col):
    n_freq = HEAD_DIM // 4
    inv = ROPE_BASE ** (-jnp.arange(n_freq, dtype=jnp.float32) / n_freq)
    ang = jnp.concatenate([row.astype(jnp.float32)[:, None] * inv[None],
                           col.astype(jnp.float32)[:, None] * inv[None]], axis=-1)
    return jnp.cos(ang), jnp.sin(ang)


def apply_rope(x, cos, sin):
    half = x.shape[-1] // 2
    x1, x2 = x[..., :half], x[..., half:]
    c, s = cos[None, :, None, :], sin[None, :, None, :]
    return jnp.concatenate([x1 * c - x2 * s, x1 * s + x2 * c], axis=-1).astype(x.dtype)


def chunked_gla(q, k, v, log_a, s0):
    B, L, H, dk = q.shape
    dv = v.shape[-1]
    n = L // CHUNK

    def to_chunks(z):
        return z.reshape(B, n, CHUNK, H, z.shape[-1]).astype(jnp.float32)

    qc, kc, vc, gc = to_chunks(q), to_chunks(k), to_chunks(v), to_chunks(log_a)
    b = jnp.cumsum(gc, axis=2)
    b_last = b[:, :, -1:]
    q_in = qc * jnp.exp(b)
    k_in = kc * jnp.exp(-b)
    k_st = kc * jnp.exp(b_last - b)
    mask = jnp.tril(jnp.ones((CHUNK, CHUNK), dtype=bool))
    att = jnp.where(mask, jnp.einsum('bnthd,bnshd->bnhts', q_in, k_in), 0.0)
    o_intra = jnp.einsum('bnhts,bnshv->bnthv', att, vc)
    d_state = jnp.einsum('bnshd,bnshv->bnhdv', k_st, vc)
    decay = jnp.exp(b_last[:, :, 0])

    def step(S, inp):
        ds_n, dec_n = inp
        return dec_n[..., None] * S + ds_n, S

    s_final, s_prev = lax.scan(step, s0.astype(jnp.float32),
                               (jnp.moveaxis(d_state, 1, 0), jnp.moveaxis(decay, 1, 0)))
    s_prev = jnp.moveaxis(s_prev, 0, 1)
    o_inter = jnp.einsum('bnthd,bnhdv->bnthv', q_in, s_prev)
    o = (o_intra + o_inter).reshape(B, L, H, dv)
    return o.astype(v.dtype), s_final


def bidir_chunked(qc, kc, vc, gc_fw, gc_bw, ql, kl, vl, gl_fw, gl_bw):
    B, _, H, dk = qc.shape
    dv = vc.shape[-1]
    s0 = jnp.zeros((B, H, dk, dv), jnp.float32)
    flip = lambda z: jnp.flip(z, axis=1)
    oc_f, sc_f = chunked_gla(qc, kc, vc, gc_fw, s0)
    oc_b, sc_b = chunked_gla(flip(qc), flip(kc), flip(vc), flip(gc_bw), s0)
    ol_f, _ = chunked_gla(ql, kl, vl, gl_fw, sc_f)
    ol_b, _ = chunked_gla(flip(ql), flip(kl), flip(vl), flip(gl_bw), sc_b)
    return oc_f + flip(oc_b), ol_f + flip(ol_b)


def centred_depthwise_conv(x, w, b):
    K, C = w.shape
    left = K // 2
    y = lax.conv_general_dilated(x, w[:, None, :].astype(x.dtype), window_strides=(1,),
                                 padding=[(left, K - 1 - left)],
                                 dimension_numbers=('NWC', 'WIO', 'NWC'), feature_group_count=C)
    return y + b.astype(x.dtype)


def rg_lru_coeffs(xc, wa, ba, wx, bx, lam):
    B, L, W = xc.shape
    xb = xc.reshape(B, L, LRU_BLOCKS, W // LRU_BLOCKS)
    r = jax.nn.sigmoid(jnp.einsum('blni,nij->blnj', xb, wa).reshape(B, L, W) + ba)
    i_g = jax.nn.sigmoid(jnp.einsum('blni,nij->blnj', xb, wx).reshape(B, L, W) + bx)
    log_a = (LRU_C * r.astype(jnp.float32)) * jax.nn.log_sigmoid(lam.astype(jnp.float32))
    a = jnp.exp(log_a)
    u = jnp.sqrt(-jnp.expm1(2.0 * log_a)) * (i_g * xc).astype(jnp.float32)
    return a, u


def linear_recurrence(a, u, h0):
    def combine(l, r):
        al, ul = l
        ar, ur = r
        return al * ar, ar * ul + ur
    a_cum, h = lax.associative_scan(combine, (a, u), axis=1)
    h = h + a_cum * h0[:, None]
    return h, h[:, -1]


def bidir_lru(c_fw, c_bw, l_fw, l_bw):
    flip = lambda z: jnp.flip(z, axis=1)
    B, _, W = c_fw[0].shape
    h0 = jnp.zeros((B, W), jnp.float32)
    hc_f, sc_f = linear_recurrence(c_fw[0], c_fw[1], h0)
    hc_b, sc_b = linear_recurrence(flip(c_bw[0]), flip(c_bw[1]), h0)
    hl_f, _ = linear_recurrence(l_fw[0], l_fw[1], sc_f)
    hl_b, _ = linear_recurrence(flip(l_bw[0]), flip(l_bw[1]), sc_b)
    return hc_f + flip(hc_b), hl_f + flip(hl_b)


def gla_lru_mixer(hc, hl, w_in, gla_up_fw, gla_b_fw, gla_up_bw, gla_b_bw, gla_norm_g,
                  conv_w, conv_b, wa_fw, ba_fw, wx_fw, bx_fw, lam_fw,
                  wa_bw, ba_bw, wx_bw, bx_bw, lam_bw):
    def project(h):
        B, L, _ = h.shape
        q, k, v, g_gla, lr, xr, g_lru = split_cols(h @ w_in, EVEN_SIZES)
        q = q.reshape(B, L, GLA_HEADS, GLA_DK) * (GLA_DK ** -0.5)
        k = k.reshape(B, L, GLA_HEADS, GLA_DK)
        v = v.reshape(B, L, GLA_HEADS, GLA_DV)
        lr = lr.astype(jnp.float32)
        la_fw = (jax.nn.log_sigmoid(lr[..., :GLA_RANK] @ gla_up_fw + gla_b_fw) / GLA_TEMP
                 ).reshape(B, L, GLA_HEADS, GLA_DK)
        la_bw = (jax.nn.log_sigmoid(lr[..., GLA_RANK:] @ gla_up_bw + gla_b_bw) / GLA_TEMP
                 ).reshape(B, L, GLA_HEADS, GLA_DK)
        xc = centred_depthwise_conv(xr, conv_w, conv_b)
        co_fw = rg_lru_coeffs(xc, wa_fw, ba_fw, wx_fw, bx_fw, lam_fw)
        co_bw = rg_lru_coeffs(xc, wa_bw, ba_bw, wx_bw, bx_bw, lam_bw)
        return (q, k, v, la_fw, la_bw, g_gla), (co_fw, co_bw, g_lru)

    (qc, kc, vc, fc, bc, ggc), (lcf, lcb, glc) = project(hc)
    (ql, kl, vl, fl, bl, ggl), (llf, llb, gll) = project(hl)
    gla_c, gla_l = bidir_chunked(qc, kc, vc, fc, bc, ql, kl, vl, fl, bl)
    lru_c, lru_l = bidir_lru(lcf, lcb, llf, llb)
    y_c = jnp.concatenate([head_rms_norm(gla_c, gla_norm_g) * jax.nn.silu(ggc),
                           lru_c.astype(hc.dtype) * jax.nn.silu(glc)], axis=-1)
    y_l = jnp.concatenate([head_rms_norm(gla_l, gla_norm_g) * jax.nn.silu(ggl),
                           lru_l.astype(hl.dtype) * jax.nn.silu(gll)], axis=-1)
    return y_c, y_l


def context_attention(qc, kc, vc, sink):
    B, Lc, Hq, dh = qc.shape
    Hkv = kc.shape[2]
    G = Hq // Hkv
    qg = qc.reshape(B, Lc, Hkv, G, dh)
    s = jnp.einsum('bqhgd,bkhd->bhgqk', qg, kc).astype(jnp.float32) * (dh ** -0.5)
    sk = jnp.broadcast_to(sink.astype(jnp.float32).reshape(1, Hkv, G, 1, 1), (B, Hkv, G, Lc, 1))
    p = jax.nn.softmax(jnp.concatenate([s, sk], axis=-1), axis=-1)[..., :Lc].astype(vc.dtype)
    return jnp.einsum('bhgqk,bkhd->bqhgd', p, vc).reshape(B, Lc, Hq * dh)


def windowed_attention(q, k, v, kc, vc, sink):
    B, L, Hq, dh = q.shape
    Hkv = k.shape[2]
    G = Hq // Hkv
    Lc = kc.shape[1]
    nb = L // BLOCK
    pad = ((0, 0), (BLOCK, BLOCK), (0, 0), (0, 0))
    kp, vp = jnp.pad(k, pad), jnp.pad(v, pad)
    scale = dh ** -0.5
    sk = jnp.broadcast_to(sink.astype(jnp.float32).reshape(1, Hkv, G, 1, 1), (B, Hkv, G, BLOCK, 1))
    q_off = jnp.arange(BLOCK)[:, None]
    k_off = jnp.arange(3 * BLOCK)[None, :] - BLOCK
    near = jnp.abs(k_off - q_off) <= WINDOW

    def one_block(i):
        start = i * BLOCK
        qi = lax.dynamic_slice_in_dim(q, start, BLOCK, axis=1).reshape(B, BLOCK, Hkv, G, dh)
        ki = lax.dynamic_slice_in_dim(kp, start, 3 * BLOCK, axis=1)
        vi = lax.dynamic_slice_in_dim(vp, start, 3 * BLOCK, axis=1)
        kpos = start + k_off
        valid = near & (kpos >= 0) & (kpos < L)
        s_loc = jnp.einsum('bqhgd,bkhd->bhgqk', qi, ki).astype(jnp.float32) * scale
        s_loc = jnp.where(valid, s_loc, NEG_INF)
        s_ctx = jnp.einsum('bqhgd,bkhd->bhgqk', qi, kc).astype(jnp.float32) * scale
        p = jax.nn.softmax(jnp.concatenate([s_loc, s_ctx, sk], axis=-1), axis=-1).astype(v.dtype)
        o = (jnp.einsum('bhgqk,bkhd->bqhgd', p[..., :3 * BLOCK], vi)
             + jnp.einsum('bhgqk,bkhd->bqhgd', p[..., 3 * BLOCK:3 * BLOCK + Lc], vc))
        return o.reshape(B, BLOCK, Hq * dh)

    o = lax.map(one_block, jnp.arange(nb))
    return jnp.moveaxis(o, 0, 1).reshape(B, L, Hq * dh)


def swa_ret_mixer(hc, hl, cos, sin, w_in, sink, dec_fw, dec_bw, ret_norm_g):
    def project(h, rope):
        B, L, _ = h.shape
        q, k, v, g_swa, rq, rk, rv, g_ret = split_cols(h @ w_in, ODD_SIZES)
        q = q.reshape(B, L, SWA_QH, HEAD_DIM)
        k = k.reshape(B, L, SWA_KVH, HEAD_DIM)
        v = v.reshape(B, L, SWA_KVH, HEAD_DIM)
        rq = rq.reshape(B, L, RET_HEADS, RET_DK)
        rk = rk.reshape(B, L, RET_HEADS, RET_DK)
        rv = rv.reshape(B, L, RET_HEADS, RET_DV)
        if rope:
            q, k, rq, rk = (apply_rope(t, cos, sin) for t in (q, k, rq, rk))
        rk = rk * (RET_DK ** -0.5)
        return q, k, v, g_swa, rq, rk, rv, g_ret

    qc, kc, vc, gsc, rqc, rkc, rvc, grc = project(hc, False)
    ql, kl, vl, gsl, rql, rkl, rvl, grl = project(hl, True)
    att_c = context_attention(qc, kc, vc, sink)
    att_l = windowed_attention(ql, kl, vl, kc, vc, sink)

    def log_decay(logit, ref):
        return jnp.broadcast_to(jax.nn.log_sigmoid(logit.astype(jnp.float32))[:, None], ref.shape)

    ret_c, ret_l = bidir_chunked(rqc, rkc, rvc, log_decay(dec_fw, rkc), log_decay(dec_bw, rkc),
                                 rql, rkl, rvl, log_decay(dec_fw, rkl), log_decay(dec_bw, rkl))
    y_c = jnp.concatenate([att_c * jax.nn.silu(gsc),
                           head_rms_norm(ret_c, ret_norm_g) * jax.nn.silu(grc)], axis=-1)
    y_l = jnp.concatenate([att_l * jax.nn.silu(gsl),
                           head_rms_norm(ret_l, ret_norm_g) * jax.nn.silu(grl)], axis=-1)
    return y_c, y_l


def setup_inputs(seed: int = 0) -> dict:
    key = jax.random.key(seed)
    ks = iter(jax.random.split(key, 48))
    D = D_MODEL
    NE = (DEPTH + 1) // 2
    NO = DEPTH // 2
    lb = LRU_WIDTH // LRU_BLOCKS

    def nrm(shape, s):
        return jax.random.normal(next(ks), shape, jnp.float32) * s

    def lru_lambda():
        a0 = jax.random.uniform(next(ks), (NE, LRU_WIDTH), jnp.float32, 0.9, 0.999)
        u = a0 ** (1.0 / LRU_C)
        return jnp.log(u) - jnp.log1p(-u)

    m = 5.0 + jnp.arange(RET_HEADS, dtype=jnp.float32)
    ret_logit = jnp.log(2.0 ** m - 1.0)
    return {
        "x": nrm((BATCH, SEQ, D), 1.0),
        "c": nrm((BATCH, D), 1.0),
        "ctx": nrm((BATCH, CTX_LEN, D), 1.0),
        "c_ctx": nrm((D,), 1.0),
        "ada_w": nrm((DEPTH, D, 3 * D), 0.5 * D ** -0.5),
        "ada_b": nrm((DEPTH, 3 * D), 0.02),
        "norm_g": 1.0 + nrm((DEPTH, D), 0.02),
        "e_w_in": nrm((NE, D, EVEN_IN), D ** -0.5),
        "gla_up_fw": nrm((NE, GLA_RANK, GLA_HEADS * GLA_DK), GLA_RANK ** -0.5),
        "gla_b_fw": nrm((NE, GLA_HEADS * GLA_DK), 0.1),
        "gla_up_bw": nrm((NE, GLA_RANK, GLA_HEADS * GLA_DK), GLA_RANK ** -0.5),
        "gla_b_bw": nrm((NE, GLA_HEADS * GLA_DK), 0.1),
        "gla_norm_g": 1.0 + nrm((NE, GLA_DV), 0.02),
        "lru_conv_w": nrm((NE, LRU_CONV, LRU_WIDTH), LRU_CONV ** -0.5),
        "lru_conv_b": nrm((NE, LRU_WIDTH), 0.02),
        "lru_wa_fw": nrm((NE, LRU_BLOCKS, lb, lb), lb ** -0.5),
        "lru_ba_fw": nrm((NE, LRU_WIDTH), 0.02),
        "lru_wx_fw": nrm((NE, LRU_BLOCKS, lb, lb), lb ** -0.5),
        "lru_bx_fw": nrm((NE, LRU_WIDTH), 0.02),
        "lru_lam_fw": lru_lambda(),
        "lru_wa_bw": nrm((NE, LRU_BLOCKS, lb, lb), lb ** -0.5),
        "lru_ba_bw": nrm((NE, LRU_WIDTH), 0.02),
        "lru_wx_bw": nrm((NE, LRU_BLOCKS, lb, lb), lb ** -0.5),
        "lru_bx_bw": nrm((NE, LRU_WIDTH), 0.02),
        "lru_lam_bw": lru_lambda(),
        "e_w_out": nrm((NE, EVEN_MIX, D), EVEN_MIX ** -0.5),
        "o_w_in": nrm((NO, D, ODD_IN), D ** -0.5),
        "swa_sink": nrm((NO, SWA_QH), 0.5),
        "ret_dec_fw": ret_logit[None] + nrm((NO, RET_HEADS), 0.05),
        "ret_dec_bw": ret_logit[None] + nrm((NO, RET_HEADS), 0.05),
        "ret_norm_g": 1.0 + nrm((NO, RET_DV), 0.02),
        "o_w_out": nrm((NO, ODD_MIX, D), ODD_MIX ** -0.5),
        "final_g": 1.0 + nrm((D,), 0.02),
    }


def reference(x, c, ctx, c_ctx, ada_w, ada_b, norm_g, e_w_in, gla_up_fw, gla_b_fw, gla_up_bw, gla_b_bw,
              gla_norm_g, lru_conv_w, lru_conv_b, lru_wa_fw, lru_ba_fw, lru_wx_fw, lru_bx_fw, lru_lam_fw,
              lru_wa_bw, lru_ba_bw, lru_wx_bw, lru_bx_bw, lru_lam_bw, e_w_out, o_w_in, swa_sink,
              ret_dec_fw, ret_dec_bw, ret_norm_g, o_w_out, final_g):
    n_tok = x.shape[1]
    rows = n_tok // GRID_W
    row = jnp.repeat(jnp.arange(rows), GRID_W)
    col = jnp.tile(jnp.arange(GRID_W), rows)
    cos, sin = axial_rope_tables(row, col)
    D = x.shape[-1]
    ctx_h = ctx
    for i in range(DEPTH):
        mod_l = jax.nn.silu(c) @ ada_w[i] + ada_b[i]
        mod_c = jax.nn.silu(c_ctx) @ ada_w[i] + ada_b[i]
        sh_l, sc_l, g_l = mod_l[:, :D], mod_l[:, D:2 * D], mod_l[:, 2 * D:]
        sh_c, sc_c, g_c = mod_c[:D], mod_c[D:2 * D], mod_c[2 * D:]
        hl = rms_norm(x, norm_g[i]) * (1.0 + sc_l[:, None]) + sh_l[:, None]
        hc = rms_norm(ctx_h, norm_g[i]) * (1.0 + sc_c) + sh_c
        j = i // 2
        if i % 2 == 0:
            y_c, y_l = gla_lru_mixer(hc, hl, e_w_in[j], gla_up_fw[j], gla_b_fw[j], gla_up_bw[j], gla_b_bw[j],
                                     gla_norm_g[j], lru_conv_w[j], lru_conv_b[j],
                                     lru_wa_fw[j], lru_ba_fw[j], lru_wx_fw[j], lru_bx_fw[j], lru_lam_fw[j],
                                     lru_wa_bw[j], lru_ba_bw[j], lru_wx_bw[j], lru_bx_bw[j], lru_lam_bw[j])
            w_out = e_w_out[j]
        else:
            y_c, y_l = swa_ret_mixer(hc, hl, cos, sin, o_w_in[j], swa_sink[j], ret_dec_fw[j], ret_dec_bw[j],
                                     ret_norm_g[j])
            w_out = o_w_out[j]
        x = x + g_l[:, None] * (y_l @ w_out)
        if i < DEPTH - 1:
            ctx_h = ctx_h + g_c * (y_c @ w_out)
    return rms_norm(x, final_g)
```

```cpp
#include <hip/hip_runtime.h>
#include <hip/hip_cooperative_groups.h>
#include <cstdio>
namespace cg = cooperative_groups;

#ifndef MK_COOP
#define MK_COOP 1
#endif
#ifndef PROBE_REP
#define PROBE_REP 0
#endif
#ifndef PROBE_SYNC
#define PROBE_SYNC 0
#endif

typedef unsigned short u16;
typedef __attribute__((ext_vector_type(8))) short bf16x8;
typedef __attribute__((ext_vector_type(16))) float f32x16;

constexpr int D = 1024, NB = 2, L = 16384, LC = 256;
constexpr int NLAT = NB * L, NCTX = NB * LC, NROW = NLAT + NCTX;
constexpr int ZW = 2816;
constexpr int NPH = 26;
constexpr int LDS_BYTES = 163840;

constexpr size_t OFF_Z    = 0;
constexpr size_t OFF_HY   = OFF_Z + (size_t)NROW * ZW * 2;
constexpr size_t OFF_WIN  = OFF_HY + (size_t)NROW * 1024 * 2;
constexpr size_t OFF_WOUT = OFF_WIN + (size_t)4 * 2816 * 1024 * 2;
constexpr size_t OFF_WLRU = OFF_WOUT + (size_t)4 * 1024 * 1024 * 2;
constexpr size_t OFF_LA   = OFF_WLRU + (size_t)2 * 4 * 4 * 16384 * 2;
constexpr size_t OFF_LU   = OFF_LA + (size_t)2 * NROW * 512 * 2;
constexpr size_t OFF_GS   = OFF_LU + (size_t)2 * NROW * 512 * 2;
constexpr size_t OFF_GD   = OFF_GS + (size_t)16 * 65 * 8192 * 4;
constexpr size_t OFF_LSA  = OFF_GD + (size_t)16 * 65 * 64 * 4;
constexpr size_t OFF_LSU  = OFF_LSA + (size_t)4 * 130 * 512 * 4;
constexpr size_t OFF_MOD  = OFF_LSU + (size_t)4 * 130 * 512 * 4;
constexpr size_t OFF_CTXX = OFF_MOD + (size_t)4 * 3 * 3072 * 4;
constexpr size_t OFF_ROPE = OFF_CTXX + (size_t)NCTX * 1024 * 4;
constexpr size_t OFF_BAR  = OFF_ROPE + (size_t)256 * 16 * 8;
constexpr size_t WS_END   = OFF_BAR + 256;

struct P {
  const float* in[33];
  float* out;
  char* ws;
  int ph_lo, ph_hi;
};

struct MixCfg {
  int qcol, kcol, vcol, gcol, ycol, lrcol, ret, pad;
  const float* up0; const float* up1;
  const float* ub0; const float* ub1;
  const float* dec0; const float* dec1;
  const float* ng;
};

typedef __attribute__((ext_vector_type(2))) float f32x2_t;
typedef __attribute__((ext_vector_type(2))) __bf16 bf16x2_t;
__device__ __forceinline__ unsigned pack2(float a, float b) {
  f32x2_t f; f[0] = a; f[1] = b;
  return __builtin_bit_cast(unsigned, __builtin_convertvector(f, bf16x2_t));
}
__device__ __forceinline__ u16 f2bf(float f) { return (u16)(pack2(f, 0.f) & 0xffffu); }
__device__ __forceinline__ float bf2f(u16 h) { return __uint_as_float(((unsigned)h) << 16); }
__device__ __forceinline__ float lo2f(unsigned u) { return __uint_as_float(u << 16); }
__device__ __forceinline__ float hi2f(unsigned u) { return __uint_as_float(u & 0xffff0000u); }
__device__ __forceinline__ void unpack8(const uint4& v, float* f) {
  f[0] = lo2f(v.x); f[1] = hi2f(v.x); f[2] = lo2f(v.y); f[3] = hi2f(v.y);
  f[4] = lo2f(v.z); f[5] = hi2f(v.z); f[6] = lo2f(v.w); f[7] = hi2f(v.w);
}
__device__ __forceinline__ uint4 pack8(const float* f) {
  uint4 v; v.x = pack2(f[0], f[1]); v.y = pack2(f[2], f[3]); v.z = pack2(f[4], f[5]); v.w = pack2(f[6], f[7]); return v;
}
__device__ __forceinline__ int opq_tid() { int t = threadIdx.x; asm volatile("" : "+v"(t)); return t; }
__device__ __forceinline__ float fexp(float x) { return __builtin_amdgcn_exp2f(x * 1.4426950408889634f); }
__device__ __forceinline__ float flog(float x) { return __builtin_amdgcn_logf(x) * 0.6931471805599453f; }
__device__ __forceinline__ float sigmoidf_(float x) { return __builtin_amdgcn_rcpf(1.f + fexp(-x)); }
__device__ __forceinline__ float siluf_(float x) { return x * __builtin_amdgcn_rcpf(1.f + fexp(-x)); }
__device__ __forceinline__ float logsigf_(float x) { return fminf(x, 0.f) - flog(1.f + fexp(-fabsf(x))); }
__device__ __forceinline__ int rowof(int seq, int t) { return seq < 2 ? seq * L + t : NLAT + (seq - 2) * LC + t; }
__device__ __forceinline__ f32x16 mfma32(bf16x8 a, bf16x8 b, f32x16 c) {
  return __builtin_amdgcn_mfma_f32_32x32x16_bf16(a, b, c, 0, 0, 0);
}
typedef __attribute__((ext_vector_type(4))) float f32x4;
__device__ __forceinline__ f32x4 mfma16(bf16x8 a, bf16x8 b, f32x4 c) {
  return __builtin_amdgcn_mfma_f32_16x16x32_bf16(a, b, c, 0, 0, 0);
}
__device__ __forceinline__ f32x16 zero16() {
  f32x16 z;
#pragma unroll
  for (int i = 0; i < 16; ++i) z[i] = 0.f;
  return z;
}
#define LDS8(ptr) (*(const bf16x8*)(ptr))
typedef __attribute__((ext_vector_type(4))) short s16x4;
__device__ __forceinline__ int tr_lane_off(int lane, int stride) {
  return (8 * (lane >> 5) + ((lane & 15) >> 2)) * stride + 16 * ((lane >> 4) & 1) + 4 * (lane & 3);
}
__device__ __forceinline__ bf16x8 tr_frag(const u16* T, int stride, int ks, int c, int loff) {
  const u16* a0 = T + loff + 16 * ks * stride + 32 * c;
  const s16x4 lo = __builtin_amdgcn_ds_read_tr16_b64_v4i16((__attribute__((address_space(3))) s16x4*)(a0));
  const s16x4 hi = __builtin_amdgcn_ds_read_tr16_b64_v4i16((__attribute__((address_space(3))) s16x4*)(a0 + 4 * stride));
  bf16x8 f;
  f[0] = lo[0]; f[1] = lo[1]; f[2] = lo[2]; f[3] = lo[3]; f[4] = hi[0]; f[5] = hi[1]; f[6] = hi[2]; f[7] = hi[3];
  return f;
}

__device__ __forceinline__ void transpose_tile(const float* __restrict__ src, int ldsrc, int nvalid, int n0, int k0,
                               u16* __restrict__ dst, int lddst, int scale_mode, char* lds) {
  float* ts = (float*)lds;
  const int tid = opq_tid();
  {
    const int k = tid >> 3, n8 = (tid & 7) * 8;
    float v[8];
    if (n0 + n8 < nvalid) {
      const float4 a = *(const float4*)(src + (size_t)(k0 + k) * ldsrc + n0 + n8);
      const float4 b = *(const float4*)(src + (size_t)(k0 + k) * ldsrc + n0 + n8 + 4);
      v[0] = a.x; v[1] = a.y; v[2] = a.z; v[3] = a.w; v[4] = b.x; v[5] = b.y; v[6] = b.z; v[7] = b.w;
    } else {
#pragma unroll
      for (int j = 0; j < 8; ++j) v[j] = 0.f;
    }
#pragma unroll
    for (int j = 0; j < 8; ++j) {
      const int n = n0 + n8 + j;
      float x = v[j];
      if (scale_mode == 1) { if (n < 256) x *= 0.125f; }
      else if (scale_mode == 2) { if (n < 512 || (n >= 1536 && n < 1792)) x *= 0.125f; }
      ts[k * 65 + n8 + j] = x;
    }
  }
  __syncthreads();
  {
    const int n = tid >> 3, k8 = (tid & 7) * 8;
    float f[8];
#pragma unroll
    for (int j = 0; j < 8; ++j) f[j] = ts[(k8 + j) * 65 + n];
    if (lddst > 0) *(uint4*)(dst + (size_t)(n0 + n) * lddst + k0 + k8) = pack8(f);
    else {
      const int jj = n0 + n, ii = k0 + k8;
      *(uint4*)(dst + ((((jj >> 5) * 8 + (ii >> 4)) * 64 + (jj & 31) + 32 * ((ii >> 3) & 1)) * 8)) = pack8(f);
    }
  }
  __syncthreads();
}

__device__ __forceinline__ void phase_prep(const P& p, char* lds) {
  const int tid = opq_tid();
  constexpr int T_WIN = 4 * 44 * 16, T_WOUT = 4 * 16 * 16, T_LRU = 2 * 4 * 4 * 4, T_MOD = 96;
  constexpr int TOT = T_WIN + T_WOUT + T_LRU + T_MOD + 1;
  for (int it = blockIdx.x; it < TOT; it += gridDim.x) {
    if (it < T_WIN) {
      const int l = it / 704, rem = it % 704, ntile = rem >> 4, ktile = rem & 15;
      const bool even = (l & 1) == 0;
      const float* src = even ? p.in[7] + (size_t)(l >> 1) * 1024 * 2592 : p.in[26] + (size_t)(l >> 1) * 1024 * 2816;
      transpose_tile(src, even ? 2592 : 2816, even ? 2592 : 2816, ntile * 64, ktile * 64,
                     (u16*)(p.ws + OFF_WIN) + (size_t)l * 2816 * 1024, 1024, even ? 1 : 2, lds);
    } else if (it < T_WIN + T_WOUT) {
      const int j = it - T_WIN, l = j >> 8, rem = j & 255, ntile = rem >> 4, ktile = rem & 15;
      const float* src = ((l & 1) == 0) ? p.in[25] + (size_t)(l >> 1) * 1024 * 1024 : p.in[31] + (size_t)(l >> 1) * 1024 * 1024;
      transpose_tile(src, 1024, 1024, ntile * 64, ktile * 64, (u16*)(p.ws + OFF_WOUT) + (size_t)l * 1024 * 1024, 1024, 0, lds);
    } else if (it < T_WIN + T_WOUT + T_LRU) {
      const int j = it - T_WIN - T_WOUT;
      const int t4 = j & 3, blk = (j >> 2) & 3, mat = (j >> 4) & 3, jl = j >> 6;
      const float* srcb = mat == 0 ? p.in[15] : mat == 1 ? p.in[17] : mat == 2 ? p.in[20] : p.in[22];
      const float* src = srcb + (size_t)(jl * 4 + blk) * 16384;
      u16* dst = (u16*)(p.ws + OFF_WLRU) + (size_t)((jl * 4 + mat) * 4 + blk) * 16384;
      transpose_tile(src, 128, 128, (t4 >> 1) * 64, (t4 & 1) * 64, dst, -1, 0, lds);
    } else if (it < T_WIN + T_WOUT + T_LRU + T_MOD) {
      const int j = it - T_WIN - T_WOUT - T_LRU;
      const int l = j / 24, n0 = (j % 24) * 128;
      float* sc = (float*)lds;
      float* red = (float*)(lds + 12288);
      for (int i = tid; i < 3072; i += 512) {
        const int m = i >> 10, k = i & 1023;
        const float cv = m < 2 ? p.in[1][m * 1024 + k] : p.in[3][k];
        sc[i] = siluf_(cv);
      }
      __syncthreads();
      const int cg4 = tid & 31, ks = tid >> 5;
      float acc[3][4];
#pragma unroll
      for (int m = 0; m < 3; ++m)
#pragma unroll
        for (int q = 0; q < 4; ++q) acc[m][q] = 0.f;
      const float* wp = p.in[4] + (size_t)l * 1024 * 3072 + n0 + cg4 * 4;
#pragma unroll 8
      for (int kk = 0; kk < 64; ++kk) {
        const int k = ks * 64 + kk;
        const float4 wv = *(const float4*)(wp + (size_t)k * 3072);
#pragma unroll
        for (int m = 0; m < 3; ++m) {
          const float s = sc[m * 1024 + k];
          acc[m][0] += s * wv.x; acc[m][1] += s * wv.y; acc[m][2] += s * wv.z; acc[m][3] += s * wv.w;
        }
      }
#pragma unroll
      for (int m = 0; m < 3; ++m)
#pragma unroll
        for (int q = 0; q < 4; ++q) red[(ks * 3 + m) * 128 + cg4 * 4 + q] = acc[m][q];
      __syncthreads();
      if (tid < 384) {
        const int m = tid >> 7, n = tid & 127;
        float s = 0.f;
        for (int k2 = 0; k2 < 16; ++k2) s += red[(k2 * 3 + m) * 128 + n];
        ((float*)(p.ws + OFF_MOD))[(l * 3 + m) * 3072 + n0 + n] = s + p.in[5][l * 3072 + n0 + n];
      }
      __syncthreads();
    } else {
      float2* rt = (float2*)(p.ws + OFF_ROPE);
      for (int i = tid; i < 4096; i += 512) {
        const int pos = i >> 4, f = i & 15;
        const float inv = powf(10000.f, -(float)f / 16.f);
        const float ang = (float)pos * inv;
        float s, c;
        sincosf(ang, &s, &c);
        rt[i] = make_float2(c, s);
      }
    }
  }
}

__device__ __forceinline__ const float* resid_src(const P& p, int l, int row) {
  if (row < NLAT) return (l == 0 ? p.in[0] : p.out) + (size_t)row * 1024;
  return (l == 0 ? p.in[2] : (const float*)(p.ws + OFF_CTXX)) + (size_t)(row - NLAT) * 1024;
}

__device__ __forceinline__ void phase_norm(const P& p, int l) {
  const int tid = opq_tid(), lane = tid & 63, w = tid >> 6;
  u16* H = (u16*)(p.ws + OFF_HY);
  const float* g = p.in[6] + l * 1024;
  const int stride = gridDim.x * 8;
  for (int row0 = blockIdx.x * 8 + w; row0 < NROW; row0 += 2 * stride) {
    const int row1 = row0 + stride;
    const bool has1 = row1 < NROW;
    const float* s0 = resid_src(p, l, row0);
    const float* s1 = resid_src(p, l, has1 ? row1 : row0);
    float4 v0[4], v1[4];
#pragma unroll
    for (int i = 0; i < 4; ++i) v0[i] = ((const float4*)s0)[lane + 64 * i];
#pragma unroll
    for (int i = 0; i < 4; ++i) v1[i] = ((const float4*)s1)[lane + 64 * i];
#pragma unroll
    for (int rr = 0; rr < 2; ++rr) {
      if (rr == 1 && !has1) break;
      const int row = rr ? row1 : row0;
      const int m = row < L ? 0 : (row < NLAT ? 1 : 2);
      const float* mod = (const float*)(p.ws + OFF_MOD) + (l * 3 + m) * 3072;
      float ss = 0.f;
#pragma unroll
      for (int i = 0; i < 4; ++i) {
        const float4 v = rr ? v1[i] : v0[i];
        ss += v.x * v.x + v.y * v.y + v.z * v.z + v.w * v.w;
      }
#pragma unroll
      for (int o = 32; o >= 1; o >>= 1) ss += __shfl_xor(ss, o);
      const float rstd = rsqrtf(ss * (1.f / 1024.f) + 1e-6f);
#pragma unroll
      for (int i = 0; i < 4; ++i) {
        const float4 v = rr ? v1[i] : v0[i];
        const int c = (lane + 64 * i) * 4;
        const float4 gg = *(const float4*)(g + c);
        const float4 sh = *(const float4*)(mod + c);
        const float4 sc = *(const float4*)(mod + 1024 + c);
        const float h0 = (v.x * rstd * gg.x) * (1.f + sc.x) + sh.x;
        const float h1 = (v.y * rstd * gg.y) * (1.f + sc.y) + sh.y;
        const float h2 = (v.z * rstd * gg.z) * (1.f + sc.z) + sh.z;
        const float h3 = (v.w * rstd * gg.w) * (1.f + sc.w) + sh.w;
        uint2 o2; o2.x = pack2(h0, h1); o2.y = pack2(h2, h3);
        *(uint2*)(H + (size_t)row * 1024 + c) = o2;
      }
    }
  }
}

__device__ __forceinline__ void phase_final(const P& p) {
  const int tid = opq_tid(), lane = tid & 63, w = tid >> 6;
  const float* g = p.in[32];
  const int stride = gridDim.x * 8;
  float4 gg[4];
#pragma unroll
  for (int i = 0; i < 4; ++i) gg[i] = *(const float4*)(g + (lane + 64 * i) * 4);
  for (int row0 = blockIdx.x * 8 + w; row0 < NLAT; row0 += 2 * stride) {
    const int row1 = row0 + stride;
    const bool has1 = row1 < NLAT;
    float* s0 = p.out + (size_t)row0 * 1024;
    float* s1 = p.out + (size_t)(has1 ? row1 : row0) * 1024;
    float4 v0[4], v1[4];
#pragma unroll
    for (int i = 0; i < 4; ++i) v0[i] = ((const float4*)s0)[lane + 64 * i];
#pragma unroll
    for (int i = 0; i < 4; ++i) v1[i] = ((const float4*)s1)[lane + 64 * i];
#pragma unroll
    for (int rr = 0; rr < 2; ++rr) {
      if (rr == 1 && !has1) break;
      float* dst = rr ? s1 : s0;
      float ss = 0.f;
#pragma unroll
      for (int i = 0; i < 4; ++i) {
        const float4 v = rr ? v1[i] : v0[i];
        ss += v.x * v.x + v.y * v.y + v.z * v.z + v.w * v.w;
      }
#pragma unroll
      for (int o = 32; o >= 1; o >>= 1) ss += __shfl_xor(ss, o);
      const float rstd = rsqrtf(ss * (1.f / 1024.f) + 1e-6f);
#pragma unroll
      for (int i = 0; i < 4; ++i) {
        const float4 v = rr ? v1[i] : v0[i];
        float4 o4;
        o4.x = v.x * rstd * gg[i].x; o4.y = v.y * rstd * gg[i].y; o4.z = v.z * rstd * gg[i].z; o4.w = v.w * rstd * gg[i].w;
        ((float4*)dst)[lane + 64 * i] = o4;
      }
    }
  }
}

#define WAIT_V(n) asm volatile("s_waitcnt vmcnt(" #n ")" ::: "memory")
#define WAIT_L0() asm volatile("s_waitcnt lgkmcnt(0)" ::: "memory")
constexpr int GSTG = 49152;

__device__ __forceinline__ void glds16(const u16* g, char* l) {
  __builtin_amdgcn_global_load_lds((const unsigned*)g, (__attribute__((address_space(3))) unsigned*)l, 16, 0, 0);
}
__device__ __forceinline__ void gemm_piece(const u16* __restrict__ Ag, const u16* __restrict__ Bg, int k0, char* stg, int tid, int i) {
  if (i < 4) glds16(Ag + (size_t)i * 64 * 1024 + k0, stg + tid * 16 + i * 8192);
  else glds16(Bg + (size_t)(i - 4) * 64 * 1024 + k0, stg + 32768 + tid * 16 + (i - 4) * 8192);
}

#define WAIT_VN(n) asm volatile("s_waitcnt vmcnt(%0)" ::"n"(n) : "memory")
template <bool XPF>
__device__ __forceinline__ void gemm_core(const u16* __restrict__ A, const u16* __restrict__ Bt, int m0, int n0,
                                          char* lds, f32x16 (&acc)[2][2], bool first, bool has_next, int m0n, int n0n,
                                          const float* xsrc, float4 (&xr)[16]) {
  const int tid = opq_tid(), lane = tid & 63, w = tid >> 6, r = lane & 31, hh = lane >> 5;
  const int wm = w >> 1, wn = w & 1;
#pragma unroll
  for (int mi = 0; mi < 2; ++mi)
#pragma unroll
    for (int ni = 0; ni < 2; ++ni) acc[mi][ni] = zero16();
  const int srow = tid >> 3;
  const int gch = (tid & 7) ^ ((srow >> 1) & 7);
  const u16* Ag = A + (size_t)(m0 + srow) * 1024 + gch * 8;
  const u16* Bg = Bt + (size_t)(n0 + srow) * 1024 + gch * 8;
  const int g = (r >> 1) & 7;
  const int aoff = (wm * 64 + r) * 128;
  const int boff = 32768 + (wn * 64 + r) * 128;
  int koff[4];
#pragma unroll
  for (int ks = 0; ks < 4; ++ks) koff[ks] = ((ks * 2 + hh) ^ g) * 16;
  if (first) {
    WAIT_V(0);
    __builtin_amdgcn_s_barrier();
#pragma unroll
    for (int i = 0; i < 6; ++i) gemm_piece(Ag, Bg, 0, lds, tid, i);
#pragma unroll
    for (int i = 0; i < 6; ++i) gemm_piece(Ag, Bg, 64, lds + GSTG, tid, i);
  }
  if (!XPF) {
#pragma unroll 1
    for (int kt = 0; kt < 16; ++kt) {
      if (kt == 15) WAIT_V(0);
      else if (first || kt >= 2) WAIT_V(6);
      else if (kt == 0) WAIT_V(8);
      else WAIT_V(14);
    __builtin_amdgcn_s_barrier();
      const char* st = lds + (kt % 3) * GSTG;
      char* nst = lds + ((kt + 2) % 3) * GSTG;
      const bool more = kt + 2 < 16;
      const int k2 = (kt + 2) * 64;
      bf16x8 a0 = LDS8(st + aoff + koff[0]);
      bf16x8 a1 = LDS8(st + aoff + 32 * 128 + koff[0]);
      bf16x8 b0 = LDS8(st + boff + koff[0]);
      bf16x8 b1 = LDS8(st + boff + 32 * 128 + koff[0]);
#pragma unroll
      for (int ks = 0; ks < 4; ++ks) {
        bf16x8 na0 = a0, na1 = a1, nb0 = b0, nb1 = b1;
        if (ks < 3) {
          na0 = LDS8(st + aoff + koff[ks + 1]);
          na1 = LDS8(st + aoff + 32 * 128 + koff[ks + 1]);
          nb0 = LDS8(st + boff + koff[ks + 1]);
          nb1 = LDS8(st + boff + 32 * 128 + koff[ks + 1]);
        }
        if (more) {
          if (ks == 0) { gemm_piece(Ag, Bg, k2, nst, tid, 0); gemm_piece(Ag, Bg, k2, nst, tid, 1); }
          else if (ks == 1) { gemm_piece(Ag, Bg, k2, nst, tid, 2); gemm_piece(Ag, Bg, k2, nst, tid, 3); }
          else if (ks == 2) gemm_piece(Ag, Bg, k2, nst, tid, 4);
          else gemm_piece(Ag, Bg, k2, nst, tid, 5);
        }
        acc[0][0] = mfma32(a0, b0, acc[0][0]);
        acc[0][1] = mfma32(a0, b1, acc[0][1]);
        acc[1][0] = mfma32(a1, b0, acc[1][0]);
        acc[1][1] = mfma32(a1, b1, acc[1][1]);
        a0 = na0; a1 = na1; b0 = nb0; b1 = nb1;
      }
      }
  } else {
#pragma unroll
    for (int kt = 0; kt < 16; ++kt) {
      if (kt == 0) { if (first) WAIT_V(6); else WAIT_V(16); }
      else if (kt == 1) { if (first) WAIT_V(7); else WAIT_V(23); }
      else if (kt < 15) WAIT_V(8);
      else WAIT_V(2);
    __builtin_amdgcn_s_barrier();
      const char* st = lds + (kt % 3) * GSTG;
      char* nst = lds + ((kt + 2) % 3) * GSTG;
      const bool more = kt + 2 < 16;
      const int k2 = (kt + 2) * 64;
      bf16x8 a0 = LDS8(st + aoff + koff[0]);
      bf16x8 a1 = LDS8(st + aoff + 32 * 128 + koff[0]);
      bf16x8 b0 = LDS8(st + boff + koff[0]);
      bf16x8 b1 = LDS8(st + boff + 32 * 128 + koff[0]);
#pragma unroll
      for (int ks = 0; ks < 4; ++ks) {
        bf16x8 na0 = a0, na1 = a1, nb0 = b0, nb1 = b1;
        if (ks < 3) {
          na0 = LDS8(st + aoff + koff[ks + 1]);
          na1 = LDS8(st + aoff + 32 * 128 + koff[ks + 1]);
          nb0 = LDS8(st + boff + koff[ks + 1]);
          nb1 = LDS8(st + boff + 32 * 128 + koff[ks + 1]);
        }
        if (more) {
          if (ks == 0) { gemm_piece(Ag, Bg, k2, nst, tid, 0); gemm_piece(Ag, Bg, k2, nst, tid, 1); }
          else if (ks == 1) { gemm_piece(Ag, Bg, k2, nst, tid, 2); gemm_piece(Ag, Bg, k2, nst, tid, 3); }
          else if (ks == 2) gemm_piece(Ag, Bg, k2, nst, tid, 4);
          else gemm_piece(Ag, Bg, k2, nst, tid, 5);
        }
        acc[0][0] = mfma32(a0, b0, acc[0][0]);
        acc[0][1] = mfma32(a0, b1, acc[0][1]);
        acc[1][0] = mfma32(a1, b0, acc[1][0]);
        acc[1][1] = mfma32(a1, b1, acc[1][1]);
        a0 = na0; a1 = na1; b0 = nb0; b1 = nb1;
      }
        __builtin_amdgcn_sched_barrier(0);
      {
        const int lr = (tid >> 5) + 16 * (kt & 7);
        const int row = (lr >> 5) * 64 + (kt >> 3) * 32 + (lr & 31);
        xr[kt] = *(const float4*)(xsrc + (size_t)row * 1024);
      }
      __builtin_amdgcn_sched_barrier(0);
    }
  }
  __builtin_amdgcn_s_barrier();
  if (has_next) {
    const u16* Agn = A + (size_t)(m0n + srow) * 1024 + gch * 8;
    const u16* Bgn = Bt + (size_t)(n0n + srow) * 1024 + gch * 8;
#pragma unroll
    for (int i = 0; i < 6; ++i) gemm_piece(Agn, Bgn, 0, lds, tid, i);
#pragma unroll
    for (int i = 0; i < 6; ++i) gemm_piece(Agn, Bgn, 64, lds + GSTG, tid, i);
  }
}

template <bool XPF>
__device__ __forceinline__ void gemm_core16(const u16* __restrict__ A, const u16* __restrict__ Bt, int m0, int n0,
                                          char* lds, f32x4 (&acc)[4][4], bool first, bool has_next, int m0n, int n0n,
                                          const float* xsrc, float4 (&xr)[16]) {
  const int tid = opq_tid(), lane = tid & 63, w = tid >> 6, r16 = lane & 15, q4 = lane >> 4;
  const int wm = w >> 1, wn = w & 1;
#pragma unroll
  for (int mi = 0; mi < 4; ++mi)
#pragma unroll
    for (int ni = 0; ni < 4; ++ni) { acc[mi][ni][0] = 0.f; acc[mi][ni][1] = 0.f; acc[mi][ni][2] = 0.f; acc[mi][ni][3] = 0.f; }
  const int srow = tid >> 3;
  const int gch = (tid & 7) ^ ((srow >> 1) & 7);
  const u16* Ag = A + (size_t)(m0 + srow) * 1024 + gch * 8;
  const u16* Bg = Bt + (size_t)(n0 + srow) * 1024 + gch * 8;
  const int g = (r16 >> 1) & 7;
  const int aoff = (wm * 64 + r16) * 128;
  const int boff = 32768 + (wn * 64 + r16) * 128;
  int koff[2];
#pragma unroll
  for (int ks = 0; ks < 2; ++ks) koff[ks] = ((ks * 4 + q4) ^ g) * 16;
  if (first) {
    WAIT_V(0);
    __builtin_amdgcn_s_barrier();
#pragma unroll
    for (int i = 0; i < 6; ++i) gemm_piece(Ag, Bg, 0, lds, tid, i);
#pragma unroll
    for (int i = 0; i < 6; ++i) gemm_piece(Ag, Bg, 64, lds + GSTG, tid, i);
  }
#define GEMM_KTILE_BODY                                                                               \
      __builtin_amdgcn_s_barrier();                                                                   \
      const char* st = lds + (kt % 3) * GSTG;                                                         \
      char* nst = lds + ((kt + 2) % 3) * GSTG;                                                        \
      const bool more = kt + 2 < 16;                                                                  \
      const int k2 = (kt + 2) * 64;                                                                   \
      bf16x8 af[2][4], bfr[2][4];                                                                     \
      _Pragma("unroll") for (int ks = 0; ks < 2; ++ks)                                                \
        _Pragma("unroll") for (int i = 0; i < 4; ++i) {                                               \
          af[ks][i] = LDS8(st + aoff + i * 2048 + koff[ks]);                                          \
          bfr[ks][i] = LDS8(st + boff + i * 2048 + koff[ks]);                                         \
        }                                                                                             \
      if (more) {                                                                                     \
        _Pragma("unroll") for (int i = 0; i < 6; ++i) gemm_piece(Ag, Bg, k2, nst, tid, i);            \
      }                                                                                               \
      _Pragma("unroll") for (int ks = 0; ks < 2; ++ks)                                                \
        _Pragma("unroll") for (int mi = 0; mi < 4; ++mi)                                              \
          _Pragma("unroll") for (int ni = 0; ni < 4; ++ni) acc[mi][ni] = mfma16(af[ks][mi], bfr[ks][ni], acc[mi][ni]);
  if (!XPF) {
#pragma unroll
    for (int kt = 0; kt < 16; ++kt) {
      if (kt == 15) WAIT_V(0);
      else if (first || kt >= 2) WAIT_V(6);
      else if (kt == 0) WAIT_V(8);
      else WAIT_V(14);
      GEMM_KTILE_BODY
    }
  } else {
#pragma unroll
    for (int kt = 0; kt < 16; ++kt) {
      if (kt == 0) { if (first) WAIT_V(6); else WAIT_V(16); }
      else if (kt == 1) { if (first) WAIT_V(7); else WAIT_V(23); }
      else if (kt < 15) WAIT_V(8);
      else WAIT_V(2);
      GEMM_KTILE_BODY
      __builtin_amdgcn_sched_barrier(0);
      {
        const int lr = (tid >> 5) + 16 * (kt & 7);
        const int row = (lr >> 5) * 64 + (kt >> 3) * 32 + (lr & 31);
        xr[kt] = *(const float4*)(xsrc + (size_t)row * 1024);
      }
      __builtin_amdgcn_sched_barrier(0);
    }
  }
#undef GEMM_KTILE_BODY
  __builtin_amdgcn_s_barrier();
  if (has_next) {
    const u16* Agn = A + (size_t)(m0n + srow) * 1024 + gch * 8;
    const u16* Bgn = Bt + (size_t)(n0n + srow) * 1024 + gch * 8;
#pragma unroll
    for (int i = 0; i < 6; ++i) gemm_piece(Agn, Bgn, 0, lds, tid, i);
#pragma unroll
    for (int i = 0; i < 6; ++i) gemm_piece(Agn, Bgn, 64, lds + GSTG, tid, i);
  }
}

__device__ __forceinline__ void phase_gemm_in(const P& p, int l, char* lds) {
  const int tid = opq_tid(), lane = tid & 63, w = tid >> 6, r16 = lane & 15, q4 = lane >> 4;
  const int wm = w >> 1, wn = w & 1;
  const bool odd = (l & 1) != 0;
  const int NT = odd ? 22 : 21;
  const u16* A = (const u16*)(p.ws + OFF_HY);
  const u16* Bt = (const u16*)(p.ws + OFF_WIN) + (size_t)l * 2816 * 1024;
  u16* Z = (u16*)(p.ws + OFF_Z);
  const float rinv = powf(10000.f, -(float)r16 / 16.f);
  const int xcd = blockIdx.x & 7, slot = blockIdx.x >> 3, nslot = gridDim.x >> 3;
  const int nmt = (130 - xcd + 7) >> 3;
  bool first = true;
  for (int q = slot; q < nmt * NT; q += nslot) {
    const int mt = xcd + 8 * (q / NT), nt = q % NT;
    const int m0 = mt * 256, n0 = nt * 128;
    const int q2 = q + nslot;
    const bool has_next = q2 < nmt * NT;
    f32x4 acc[4][4];
    float4 xdummy[16];
    gemm_core16<false>(A, Bt, m0, n0, lds, acc, first, has_next, (xcd + 8 * (q2 / NT)) * 256, (q2 % NT) * 128, nullptr, xdummy);
    first = false;
    const int cb = n0 + wn * 64;
    if (odd && mt < 128 && (cb < 640 || (cb >= 1280 && cb < 1792))) {
#pragma unroll
      for (int mi = 0; mi < 4; ++mi)
#pragma unroll
        for (int j = 0; j < 4; ++j) {
          const int row = m0 + wm * 64 + mi * 16 + q4 * 4 + j;
          const int tt = row & (L - 1);
#pragma unroll
          for (int ni = 0; ni < 2; ++ni) {
            const float ang = (float)(ni == 0 ? (tt >> 6) : (tt & 63)) * rinv;
            const float sn = __sinf(ang), cn = __cosf(ang);
            const float x1 = acc[mi][ni][j], x2 = acc[mi][ni + 2][j];
            acc[mi][ni][j] = x1 * cn - x2 * sn;
            acc[mi][ni + 2][j] = x1 * sn + x2 * cn;
          }
        }
    }
    {
      u16* C_s = (u16*)(lds + 2 * GSTG);
#pragma unroll
      for (int mi = 0; mi < 4; ++mi)
#pragma unroll
        for (int ni = 0; ni < 4; ++ni)
#pragma unroll
          for (int j = 0; j < 4; ++j)
            C_s[(wm * 64 + mi * 16 + q4 * 4 + j) * 128 + wn * 64 + ni * 16 + r16] = f2bf(acc[mi][ni][j]);
      __syncthreads();
#pragma unroll
      for (int it = 0; it < 8; ++it) {
        const int cc = tid + 512 * it, row = cc >> 4, c16 = cc & 15;
        *(uint4*)(Z + (size_t)(m0 + row) * ZW + n0 + c16 * 8) = *(const uint4*)(C_s + row * 128 + c16 * 8);
      }
    }
  }
}

__device__ __forceinline__ void phase_gemm_out(const P& p, int l, char* lds) {
  const int tid = opq_tid(), lane = tid & 63, w = tid >> 6, r = lane & 31, hh = lane >> 5;
  const int wm = w >> 1, wn = w & 1;
  const u16* A = (const u16*)(p.ws + OFF_HY);
  const u16* Bt = (const u16*)(p.ws + OFF_WOUT) + (size_t)l * 1024 * 1024;
  const int MT = (l == 3) ? 128 : 130;
  const int xcd = blockIdx.x & 7, slot = blockIdx.x >> 3, nslot = gridDim.x >> 3;
  const int nmt = (MT - xcd + 7) >> 3;
  bool first = true;
  for (int q = slot; q < nmt * 8; q += nslot) {
    const int mt = xcd + 8 * (q >> 3), nt = q & 7;
    const int m0 = mt * 256, n0 = nt * 128;
    const int q2 = q + nslot;
    const bool has_next = q2 < nmt * 8;
    const int m = mt < 64 ? 0 : (mt < 128 ? 1 : 2);
    const float* gate = (const float*)(p.ws + OFF_MOD) + (l * 3 + m) * 3072 + 2048;
    const float* src; float* dst;
    if (mt < 128) { src = (l == 0 ? p.in[0] : p.out) + (size_t)m0 * 1024; dst = p.out + (size_t)m0 * 1024; }
    else { src = (l == 0 ? p.in[2] : (const float*)(p.ws + OFF_CTXX)) + (size_t)(m0 - NLAT) * 1024; dst = (float*)(p.ws + OFF_CTXX) + (size_t)(m0 - NLAT) * 1024; }
    f32x16 acc[2][2];
    float4 xr[16];
    gemm_core<true>(A, Bt, m0, n0, lds, acc, first, has_next, (xcd + 8 * (q2 >> 3)) * 256, (q2 & 7) * 128, src + n0 + (tid & 31) * 4, xr);
    first = false;
    {
      float* C_f = (float*)(lds + 2 * GSTG);
      const int c4 = (tid & 31) * 4;
      const float4 gv = *(const float4*)(gate + n0 + c4);
#pragma unroll
      for (int mi = 0; mi < 2; ++mi) {
        if (mi) __syncthreads();
#pragma unroll
        for (int ni = 0; ni < 2; ++ni)
#pragma unroll
          for (int i = 0; i < 16; ++i)
            C_f[(wm * 32 + 8 * (i >> 2) + 4 * hh + (i & 3)) * 128 + wn * 64 + ni * 32 + r] = acc[mi][ni][i];
        __syncthreads();
#pragma unroll
        for (int it = 0; it < 8; ++it) {
          const int lr = (tid >> 5) + 16 * it;
          const int row = (lr >> 5) * 64 + mi * 32 + (lr & 31);
          const float4 a4 = *(const float4*)(C_f + lr * 128 + c4);
          const size_t o = (size_t)row * 1024 + n0 + c4;
          const float4 x4 = xr[mi * 8 + it];
          float4 y4;
          y4.x = x4.x + gv.x * a4.x; y4.y = x4.y + gv.y * a4.y; y4.z = x4.z + gv.z * a4.z; y4.w = x4.w + gv.w * a4.w;
          *(float4*)(dst + o) = y4;
        }
      }
    }
  }
}

__device__ __forceinline__ void gla_dir_pass(const P& p, const MixCfg& c, int b, int h, int dir, int pidx, char* lds, const bool OUT, bool second,
                                             const int cend, const int cout_from, const bool write_state) {
  const int tid = opq_tid(), lane = tid & 63, w = tid >> 6, r = lane & 31, hh = lane >> 5;
  float* lr_s = (float*)(lds);
  float* b_s = (float*)(lds + 4096);
  float* tot_s = (float*)(lds + 20480);
  float* blast_s = (float*)(lds + 22528);
  u16* qin_s = (u16*)(lds + 22784);
  u16* kin_s = (u16*)(lds + 32000);
  u16* kst_s = (u16*)(lds + 41216);
  u16* V_s = (u16*)(lds + 53504);
  u16* St_s = (u16*)(lds + 73984);
  u16* att_s = (u16*)(lds + 92416);
  float* o_s = (float*)(lds + 101632);
  const int trk = tr_lane_off(lane, 96), trv = tr_lane_off(lane, 160);
  const u16* Z = (const u16*)(p.ws + OFF_Z);
  u16* Y = (u16*)(p.ws + OFF_HY);
  float* GS = (float*)(p.ws + OFF_GS);
  float* GD = (float*)(p.ws + OFF_GD);

  int seq, tbase;
  if (pidx == 0) { seq = 2 + b; tbase = 0; }
  else { const int seg = dir ? 64 - pidx : pidx - 1; seq = b; tbase = seg * 256; }
  const int d = tid & 63, part = tid >> 6;
  float upw[16], ubias = 0.f, lg = 0.f;
  if (!c.ret) {
#pragma unroll
    for (int rr = 0; rr < 16; ++rr) upw[rr] = (dir ? c.up1 : c.up0)[rr * 256 + h * 64 + d];
    ubias = (dir ? c.ub1 : c.ub0)[h * 64 + d];
  } else {
#pragma unroll
    for (int rr = 0; rr < 16; ++rr) upw[rr] = 0.f;
    lg = logsigf_((dir ? c.dec1 : c.dec0)[h]);
  }
  const size_t sidx = ((size_t)(dir * 2 + b) * 4 + h) * 65 + pidx;
  float* GSp = GS + sidx * 8192;
  const int mt = w >> 2, nt = w & 3;
  f32x16 accS;
  if (OUT && pidx != 0) {
#pragma unroll
    for (int i = 0; i < 16; ++i) accS[i] = GSp[(mt * 32 + 8 * (i >> 2) + 4 * hh + (i & 3)) * 128 + nt * 32 + r];
  } else {
    accS = zero16();
  }
  float sumbl = 0.f;
  uint4 lrv = make_uint4(0, 0, 0, 0), kvr, qvr = make_uint4(0, 0, 0, 0), v0r, v1r;
  uint4 o0r = make_uint4(0, 0, 0, 0), o1r = o0r, g0r = o0r, g1r = o0r;
  auto growf = [&](int cc, int row) {
    const int tbb = tbase + 64 * (dir ? 3 - cc : cc);
    return rowof(seq, dir ? tbb + 63 - row : tbb + row);
  };
  auto issue_lr = [&](int cc) {
    if (!c.ret && tid < 128)
      lrv = *(const uint4*)(Z + (size_t)growf(cc, tid >> 1) * ZW + c.lrcol + dir * 16 + (tid & 1) * 8);
  };
  auto issue_kqv = [&](int cc) {
    const u16* zr = Z + (size_t)growf(cc, tid >> 3) * ZW;
    kvr = *(const uint4*)(zr + c.kcol + h * 64 + (tid & 7) * 8);
    if (OUT) qvr = *(const uint4*)(zr + c.qcol + h * 64 + (tid & 7) * 8);
    v0r = *(const uint4*)(zr + c.vcol + h * 128 + (tid & 7) * 16);
    v1r = *(const uint4*)(zr + c.vcol + h * 128 + (tid & 7) * 16 + 8);
  };
  auto issue_epi = [&](int cc) {
    if (OUT && second) {
      const int grow = growf(cc, tid >> 3);
      const u16* yq = Y + (size_t)grow * 1024 + c.ycol + h * 128 + (tid & 7) * 16;
      o0r = *(const uint4*)(yq);
      o1r = *(const uint4*)(yq + 8);
      const u16* gq = Z + (size_t)grow * ZW + c.gcol + h * 128 + (tid & 7) * 16;
      g0r = *(const uint4*)(gq);
      g1r = *(const uint4*)(gq + 8);
    }
  };
  float ngr[16];
#pragma unroll
  for (int j = 0; j < 16; ++j) ngr[j] = (OUT && second) ? c.ng[(tid & 7) * 16 + j] : 0.f;
  issue_lr(0);
  issue_kqv(0);
  issue_epi(cout_from);
  for (int cidx = 0; cidx < cend; ++cidx) {
    const bool outc = OUT && cidx >= cout_from;
    const int tb = tbase + 64 * (dir ? 3 - cidx : cidx);
    if (!c.ret) {
      if (tid < 128) {
        const int row = tid >> 1, half = tid & 1;
        float f[8];
        unpack8(lrv, f);
#pragma unroll
        for (int j = 0; j < 8; ++j) lr_s[row * 16 + half * 8 + j] = f[j];
      }
      if (cidx + 1 < cend) issue_lr(cidx + 1);
      __syncthreads();
    }
    if (!c.ret) {
      float cumv[8];
      {
        float cum = 0.f;
#pragma unroll
        for (int jj = 0; jj < 8; ++jj) {
          const int j = part * 8 + jj;
          float x = ubias;
#pragma unroll
          for (int q = 0; q < 4; ++q) {
            const float4 l4 = *(const float4*)(lr_s + j * 16 + 4 * q);
            x += l4.x * upw[4 * q] + l4.y * upw[4 * q + 1] + l4.z * upw[4 * q + 2] + l4.w * upw[4 * q + 3];
          }
          cum += logsigf_(x) * (1.f / 16.f);
          cumv[jj] = cum;
        }
        tot_s[part * 64 + d] = cum;
      }
      __syncthreads();
      {
        float off = 0.f;
        for (int pp = 0; pp < part; ++pp) off += tot_s[pp * 64 + d];
#pragma unroll
        for (int jj = 0; jj < 8; ++jj) b_s[(part * 8 + jj) * 64 + d] = cumv[jj] + off;
        if (part == 7) blast_s[d] = cumv[7] + off;
      }
      __syncthreads();
      if (tid < 64) sumbl += blast_s[tid];
    } else {
      sumbl += 64.f * lg;
    }
    {
      const int row = tid >> 3, c8 = (tid & 7) * 8;
      const uint4 kv = kvr;
      float kf[8], bv[8], tmp[8];
      unpack8(kv, kf);
      if (!c.ret) {
        float bl8[8];
        {
          const float4 b0 = *(const float4*)(b_s + row * 64 + c8), b1 = *(const float4*)(b_s + row * 64 + c8 + 4);
          const float4 l0 = *(const float4*)(blast_s + c8), l1 = *(const float4*)(blast_s + c8 + 4);
          bv[0] = b0.x; bv[1] = b0.y; bv[2] = b0.z; bv[3] = b0.w; bv[4] = b1.x; bv[5] = b1.y; bv[6] = b1.z; bv[7] = b1.w;
          bl8[0] = l0.x; bl8[1] = l0.y; bl8[2] = l0.z; bl8[3] = l0.w; bl8[4] = l1.x; bl8[5] = l1.y; bl8[6] = l1.z; bl8[7] = l1.w;
        }
#pragma unroll
        for (int j = 0; j < 8; ++j) tmp[j] = kf[j] * fexp(-bv[j]);
        *(uint4*)(kin_s + row * 72 + c8) = pack8(tmp);
#pragma unroll
        for (int j = 0; j < 8; ++j) tmp[j] = kf[j] * fexp(bl8[j] - bv[j]);
        *(uint4*)(kst_s + row * 96 + c8) = pack8(tmp);
      } else {
        const float bb = (float)(row + 1) * lg;
        const float e1 = fexp(-bb), e2 = fexp(64.f * lg - bb);
#pragma unroll
        for (int j = 0; j < 8; ++j) { bv[j] = bb; tmp[j] = kf[j] * e1; }
        *(uint4*)(kin_s + row * 72 + c8) = pack8(tmp);
#pragma unroll
        for (int j = 0; j < 8; ++j) tmp[j] = kf[j] * e2;
        *(uint4*)(kst_s + row * 96 + c8) = pack8(tmp);
      }
      if (outc) {
        const uint4 qv = qvr;
        float qf[8];
        unpack8(qv, qf);
#pragma unroll
        for (int j = 0; j < 8; ++j) tmp[j] = qf[j] * fexp(bv[j]);
        *(uint4*)(qin_s + row * 72 + c8) = pack8(tmp);
      }
      const int v16 = (tid & 7) * 16;
      *(uint4*)(V_s + row * 160 + v16) = v0r;
      *(uint4*)(V_s + row * 160 + v16 + 8) = v1r;
      if (outc) {
#pragma unroll
        for (int g = 0; g < 4; ++g) {
          uint2 s2;
          s2.x = pack2(accS[4 * g], accS[4 * g + 1]);
          s2.y = pack2(accS[4 * g + 2], accS[4 * g + 3]);
          *(uint2*)(St_s + (nt * 32 + r) * 72 + mt * 32 + 8 * g + 4 * hh) = s2;
        }
      }
      if (cidx + 1 < cend) issue_kqv(cidx + 1);
    }
    __syncthreads();
    if (outc) {
      if (w < 4) {
        const int ms = w >> 1, ntq = w & 1;
        f32x16 a = zero16();
#pragma unroll
        for (int ks = 0; ks < 4; ++ks)
          a = mfma32(LDS8(kin_s + (ms * 32 + r) * 72 + ks * 16 + hh * 8), LDS8(qin_s + (ntq * 32 + r) * 72 + ks * 16 + hh * 8), a);
        const int t = ntq * 32 + r;
#pragma unroll
        for (int g = 0; g < 4; ++g) {
          const int s0 = ms * 32 + 8 * g + 4 * hh;
          float f[4];
#pragma unroll
          for (int j = 0; j < 4; ++j) f[j] = (s0 + j <= t) ? a[4 * g + j] : 0.f;
          uint2 s2;
          s2.x = pack2(f[0], f[1]); s2.y = pack2(f[2], f[3]);
          *(uint2*)(att_s + t * 72 + s0) = s2;
        }
      }
      __syncthreads();
    }
    f32x16 accO = zero16();
    const int mo = w >> 2;
    if (outc) {
#pragma unroll
      for (int ks = 0; ks < 4; ++ks)
        accO = mfma32(tr_frag(V_s, 160, ks, nt, trv), LDS8(att_s + (mo * 32 + r) * 72 + ks * 16 + hh * 8), accO);
#pragma unroll
      for (int ks = 0; ks < 4; ++ks)
        accO = mfma32(LDS8(St_s + (nt * 32 + r) * 72 + ks * 16 + hh * 8), LDS8(qin_s + (mo * 32 + r) * 72 + ks * 16 + hh * 8), accO);
    }
    if (!c.ret) {
#pragma unroll
      for (int g = 0; g < 4; ++g) {
        const float4 l4 = *(const float4*)(blast_s + mt * 32 + 8 * g + 4 * hh);
        accS[4 * g] *= fexp(l4.x); accS[4 * g + 1] *= fexp(l4.y); accS[4 * g + 2] *= fexp(l4.z); accS[4 * g + 3] *= fexp(l4.w);
      }
    } else {
      const float dk = fexp(64.f * lg);
#pragma unroll
      for (int i = 0; i < 16; ++i) accS[i] *= dk;
    }
#pragma unroll
    for (int ks = 0; ks < 4; ++ks)
      accS = mfma32(tr_frag(kst_s, 96, ks, mt, trk), tr_frag(V_s, 160, ks, nt, trv), accS);
    if (outc) {
#pragma unroll
      for (int g = 0; g < 4; ++g)
        *(float4*)(o_s + (mo * 32 + r) * 132 + nt * 32 + 8 * g + 4 * hh) = make_float4(accO[4 * g], accO[4 * g + 1], accO[4 * g + 2], accO[4 * g + 3]);
      __syncthreads();
      const int row = tid >> 3, v16 = (tid & 7) * 16;
      const int grow = rowof(seq, dir ? tb + 63 - row : tb + row);
      float vals[16];
#pragma unroll
      for (int q = 0; q < 4; ++q) {
        const float4 t4 = *(const float4*)(o_s + row * 132 + v16 + 4 * q);
        vals[4 * q] = t4.x; vals[4 * q + 1] = t4.y; vals[4 * q + 2] = t4.z; vals[4 * q + 3] = t4.w;
      }
      u16* yp = Y + (size_t)grow * 1024 + c.ycol + h * 128 + v16;
      if (!second) {
        *(uint4*)(yp) = pack8(vals);
        *(uint4*)(yp + 8) = pack8(vals + 8);
      } else {
        const uint4 o0 = o0r, o1 = o1r;
        float ob[16];
        unpack8(o0, ob);
        unpack8(o1, ob + 8);
        float ss = 0.f;
#pragma unroll
        for (int j = 0; j < 16; ++j) { vals[j] += ob[j]; ss += vals[j] * vals[j]; }
        ss += __shfl_xor(ss, 1);
        ss += __shfl_xor(ss, 2);
        ss += __shfl_xor(ss, 4);
        const float rstd = rsqrtf(ss * (1.f / 128.f) + 1e-6f);
        const uint4 g0 = g0r, g1 = g1r;
        float gf[16];
        unpack8(g0, gf);
        unpack8(g1, gf + 8);
#pragma unroll
        for (int j = 0; j < 16; ++j) vals[j] = (vals[j] * rstd * ngr[j]) * siluf_(gf[j]);
        *(uint4*)(yp) = pack8(vals);
        *(uint4*)(yp + 8) = pack8(vals + 8);
        if (cidx + 1 < cend) issue_epi(cidx + 1);
      }
    } else if (c.ret) {
      __syncthreads();
    }
  }
  if (write_state) {
#pragma unroll
    for (int i = 0; i < 16; ++i) GSp[(mt * 32 + 8 * (i >> 2) + 4 * hh + (i & 3)) * 128 + nt * 32 + r] = accS[i];
    if (tid < 64) GD[sidx * 64 + tid] = fexp(sumbl);
  }
  __syncthreads();
}

__device__ __forceinline__ void gla_passA(const P& p, const MixCfg& c, int b, int h, int seq, int tbase, int pf, int pb, char* lds) {
  const int tid = opq_tid(), lane = tid & 63, w = tid >> 6, r = lane & 31, hh = lane >> 5;
  float* lr_s = (float*)(lds);
  float* b_s = (float*)(lds + 8192);
  float* tot_s = (float*)(lds + 40960);
  float* blast_s = (float*)(lds + 45056);
  float* dacc_s = (float*)(lds + 45568);
  u16* kst_s = (u16*)(lds + 45824);
  u16* V_s = (u16*)(lds + 70400);
  const u16* Z = (const u16*)(p.ws + OFF_Z);
  float* GS = (float*)(p.ws + OFF_GS);
  float* GD = (float*)(p.ws + OFF_GD);
  const int trk = tr_lane_off(lane, 96), trv = tr_lane_off(lane, 160);
  const int dir2 = tid >> 8, d = tid & 63, part = (tid >> 6) & 3;
  float upw[16], ubias = 0.f;
  const float lgf = c.ret ? logsigf_(c.dec0[h]) : 0.f, lgb = c.ret ? logsigf_(c.dec1[h]) : 0.f;
  if (!c.ret) {
#pragma unroll
    for (int rr = 0; rr < 16; ++rr) upw[rr] = (dir2 ? c.up1 : c.up0)[rr * 256 + h * 64 + d];
    ubias = (dir2 ? c.ub1 : c.ub0)[h * 64 + d];
  } else {
#pragma unroll
    for (int rr = 0; rr < 16; ++rr) upw[rr] = 0.f;
  }
  const int mt = w >> 2, nt = w & 3;
  f32x16 accF = zero16(), accB = zero16();
  float sumf = 0.f, sumb = 0.f;
  uint4 lrv = make_uint4(0, 0, 0, 0), kvr, v0r, v1r;
  auto issue = [&](int cc) {
    const int tb = tbase + 64 * cc;
    if (!c.ret && tid < 256) lrv = *(const uint4*)(Z + (size_t)rowof(seq, tb + (tid >> 2)) * ZW + c.lrcol + (tid & 3) * 8);
    const u16* zr = Z + (size_t)rowof(seq, tb + (tid >> 3)) * ZW;
    kvr = *(const uint4*)(zr + c.kcol + h * 64 + (tid & 7) * 8);
    v0r = *(const uint4*)(zr + c.vcol + h * 128 + (tid & 7) * 16);
    v1r = *(const uint4*)(zr + c.vcol + h * 128 + (tid & 7) * 16 + 8);
  };
  issue(0);
  if (tid < 64) dacc_s[tid] = 0.f;
  for (int cidx = 0; cidx < 4; ++cidx) {
    if (!c.ret) {
      if (tid < 256) {
        float f[8];
        unpack8(lrv, f);
#pragma unroll
        for (int j = 0; j < 8; ++j) lr_s[(tid >> 2) * 32 + (tid & 3) * 8 + j] = f[j];
      }
      __syncthreads();
      float cumv[16];
      {
        float cum = 0.f;
#pragma unroll
        for (int jj = 0; jj < 16; ++jj) {
          const int j = part * 16 + jj;
          float x = ubias;
#pragma unroll
          for (int q = 0; q < 4; ++q) {
            const float4 l4 = *(const float4*)(lr_s + j * 32 + dir2 * 16 + 4 * q);
            x += l4.x * upw[4 * q] + l4.y * upw[4 * q + 1] + l4.z * upw[4 * q + 2] + l4.w * upw[4 * q + 3];
          }
          cum += logsigf_(x) * (1.f / 16.f);
          cumv[jj] = cum;
        }
        tot_s[(dir2 * 4 + part) * 64 + d] = cum;
      }
      __syncthreads();
      {
        float off = 0.f;
        for (int pp = 0; pp < part; ++pp) off += tot_s[(dir2 * 4 + pp) * 64 + d];
#pragma unroll
        for (int jj = 0; jj < 16; ++jj) b_s[(dir2 * 64 + part * 16 + jj) * 64 + d] = cumv[jj] + off;
        if (part == 3) blast_s[dir2 * 64 + d] = cumv[15] + off;
      }
      __syncthreads();
    }
    {
      const int row = tid >> 3, c8 = (tid & 7) * 8;
      float kf[8], tf[8], tb8[8];
      unpack8(kvr, kf);
      if (!c.ret) {
        float bf8[8], bl8[8], ex8[8], da8[8];
        {
          const float4 a0 = *(const float4*)(b_s + row * 64 + c8), a1 = *(const float4*)(b_s + row * 64 + c8 + 4);
          const float4 l0 = *(const float4*)(blast_s + c8), l1 = *(const float4*)(blast_s + c8 + 4);
          const float4 d0 = *(const float4*)(dacc_s + c8), d1 = *(const float4*)(dacc_s + c8 + 4);
          float4 e0 = make_float4(0.f, 0.f, 0.f, 0.f), e1 = e0;
          if (row > 0) { e0 = *(const float4*)(b_s + (64 + row - 1) * 64 + c8); e1 = *(const float4*)(b_s + (64 + row - 1) * 64 + c8 + 4); }
          bf8[0] = a0.x; bf8[1] = a0.y; bf8[2] = a0.z; bf8[3] = a0.w; bf8[4] = a1.x; bf8[5] = a1.y; bf8[6] = a1.z; bf8[7] = a1.w;
          bl8[0] = l0.x; bl8[1] = l0.y; bl8[2] = l0.z; bl8[3] = l0.w; bl8[4] = l1.x; bl8[5] = l1.y; bl8[6] = l1.z; bl8[7] = l1.w;
          da8[0] = d0.x; da8[1] = d0.y; da8[2] = d0.z; da8[3] = d0.w; da8[4] = d1.x; da8[5] = d1.y; da8[6] = d1.z; da8[7] = d1.w;
          ex8[0] = e0.x; ex8[1] = e0.y; ex8[2] = e0.z; ex8[3] = e0.w; ex8[4] = e1.x; ex8[5] = e1.y; ex8[6] = e1.z; ex8[7] = e1.w;
        }
#pragma unroll
        for (int j = 0; j < 8; ++j) {
          tf[j] = kf[j] * fexp(bl8[j] - bf8[j]);
          tb8[j] = kf[j] * fexp(ex8[j] + da8[j]);
        }
      } else {
        const float ef = fexp((float)(63 - row) * lgf), eb = fexp((float)(row + 64 * cidx) * lgb);
#pragma unroll
        for (int j = 0; j < 8; ++j) { tf[j] = kf[j] * ef; tb8[j] = kf[j] * eb; }
      }
      *(uint4*)(kst_s + row * 96 + c8) = pack8(tf);
      *(uint4*)(kst_s + (64 + row) * 96 + c8) = pack8(tb8);
      const int v16 = (tid & 7) * 16;
      *(uint4*)(V_s + row * 160 + v16) = v0r;
      *(uint4*)(V_s + row * 160 + v16 + 8) = v1r;
      if (cidx + 1 < 4) issue(cidx + 1);
    }
    __syncthreads();
    if (!c.ret) {
#pragma unroll
      for (int g = 0; g < 4; ++g) {
        const float4 l4 = *(const float4*)(blast_s + mt * 32 + 8 * g + 4 * hh);
        accF[4 * g] *= fexp(l4.x); accF[4 * g + 1] *= fexp(l4.y); accF[4 * g + 2] *= fexp(l4.z); accF[4 * g + 3] *= fexp(l4.w);
      }
    } else {
      const float dk = fexp(64.f * lgf);
#pragma unroll
      for (int i = 0; i < 16; ++i) accF[i] *= dk;
    }
#pragma unroll
    for (int ks = 0; ks < 4; ++ks) {
      const bf16x8 vb = tr_frag(V_s, 160, ks, nt, trv);
      accF = mfma32(tr_frag(kst_s, 96, ks, mt, trk), vb, accF);
      accB = mfma32(tr_frag(kst_s + 64 * 96, 96, ks, mt, trk), vb, accB);
    }
    if (!c.ret) {
      if (tid < 64) { sumf += blast_s[tid]; sumb += blast_s[64 + tid]; }
    } else {
      sumf += 64.f * lgf; sumb += 64.f * lgb;
    }
    __syncthreads();
    if (!c.ret && tid < 64) dacc_s[tid] = sumb;
  }
  {
    float* GF = GS + (((size_t)(0 * 2 + b) * 4 + h) * 65 + pf) * 8192;
    float* GB = GS + (((size_t)(1 * 2 + b) * 4 + h) * 65 + pb) * 8192;
#pragma unroll
    for (int i = 0; i < 16; ++i) {
      const int o = (mt * 32 + 8 * (i >> 2) + 4 * hh + (i & 3)) * 128 + nt * 32 + r;
      GF[o] = accF[i];
      GB[o] = accB[i];
    }
    if (tid < 64) {
      GD[(((size_t)(0 * 2 + b) * 4 + h) * 65 + pf) * 64 + tid] = fexp(sumf);
      GD[(((size_t)(1 * 2 + b) * 4 + h) * 65 + pb) * 64 + tid] = fexp(sumb);
    }
  }
  __syncthreads();
}

__device__ __forceinline__ void lru_coeff_item(const P& p, int jl, int b, int sidx, int nblk, char* lds) {
  const int tid0 = opq_tid();
  u16* xr_s = (u16*)(lds);
  u16* xcb = (u16*)(lds + 17408);
  float* xcf = (float*)(lds + 34816);
  u16* la_s = (u16*)(lds + 67584);
  u16* u_s = (u16*)(lds + 102400);
  const u16* Z = (const u16*)(p.ws + OFF_Z);
  u16* LA = (u16*)(p.ws + OFF_LA);
  u16* LU = (u16*)(p.ws + OFF_LU);
  float* LSA = (float*)(p.ws + OFF_LSA);
  float* LSU = (float*)(p.ws + OFF_LSU);
  int seq, tbase, Ls;
  if (sidx < 2) { seq = 2 + b; tbase = sidx * 128; Ls = LC; }
  else { seq = b; tbase = (sidx - 2) * 128; Ls = L; }
  const int dir0 = tid0 >> 8;
  const u16* WL = (const u16*)(p.ws + OFF_WLRU);
  const int gchl = jl * 512 + nblk * 128 + ((tid0 >> 6) & 3) * 32 + (tid0 & 31);
  const float ba = (dir0 ? p.in[21] : p.in[16])[gchl];
  const float bx = (dir0 ? p.in[23] : p.in[18])[gchl];
  const float c8l = 8.f * logsigf_((dir0 ? p.in[24] : p.in[19])[gchl]);
  float LAacc = 0.f, Uacc = 0.f;
  float w0[4], w1[4], cb0, cb1;
  {
    const int ch2 = (tid0 & 63) * 2;
    const float* cw = p.in[13] + jl * 4 * 512 + nblk * 128 + ch2;
    const float* cbp = p.in[14] + jl * 512 + nblk * 128 + ch2;
#pragma unroll
    for (int j = 0; j < 4; ++j) { w0[j] = cw[j * 512]; w1[j] = cw[j * 512 + 1]; }
    cb0 = cbp[0]; cb1 = cbp[1];
  }
  uint4 xv[3];
  auto issue_xr = [&](int stt) {
#pragma unroll
    for (int q = 0; q < 3; ++q) {
      const int cc = tid0 + 512 * q;
      const int jj = cc >> 4, c8 = (cc & 15) * 8;
      const int t = tbase + 64 * stt - 2 + jj;
      xv[q] = make_uint4(0, 0, 0, 0);
      if (cc < 67 * 16 && t >= 0 && t < Ls) xv[q] = *(const uint4*)(Z + (size_t)rowof(seq, t) * ZW + 1568 + nblk * 128 + c8);
    }
  };
  issue_xr(0);
#pragma unroll 1
  for (int st = 0; st < 2; ++st) {
    const int tid = opq_tid(), lane = tid & 63, w = tid >> 6, r = lane & 31, hh = lane >> 5;
    const int dir = w >> 2, nq = w & 3;
    const int t0 = tbase + 64 * st;
#pragma unroll
    for (int q = 0; q < 3; ++q) {
      const int cc = tid + 512 * q;
      if (cc < 67 * 16) *(uint4*)(xr_s + (cc >> 4) * 128 + (cc & 15) * 8) = xv[q];
    }
    if (st == 0) issue_xr(1);
    bf16x8 bq0[8];
    {
      const u16* wb = WL + (size_t)((jl * 4 + dir * 2 + 0) * 4 + nblk) * 16384 + (nq * 8 * 64 + lane) * 8;
#pragma unroll
      for (int ks = 0; ks < 8; ++ks) bq0[ks] = *(const bf16x8*)(wb + ks * 512);
    }
    __syncthreads();
    {
      const int ch2 = (tid & 63) * 2, r0 = (tid >> 6) * 8;
      float x0[11], x1[11];
#pragma unroll
      for (int j = 0; j < 11; ++j) {
        const unsigned u = *(const unsigned*)(xr_s + (r0 + j) * 128 + ch2);
        x0[j] = lo2f(u); x1[j] = hi2f(u);
      }
#pragma unroll
      for (int rr = 0; rr < 8; ++rr) {
        float a0 = cb0, a1 = cb1;
#pragma unroll
        for (int j = 0; j < 4; ++j) { a0 += w0[j] * x0[rr + j]; a1 += w1[j] * x1[rr + j]; }
        *(float2*)(xcf + (r0 + rr) * 128 + ch2) = make_float2(a0, a1);
        *(unsigned*)(xcb + (r0 + rr) * 136 + ch2) = pack2(a0, a1);
      }
    }
    __syncthreads();
    float lav[2][16];
#pragma unroll
    for (int mat = 0; mat < 2; ++mat) {
      const u16* wb = WL + (size_t)((jl * 4 + dir * 2 + mat) * 4 + nblk) * 16384 + (nq * 8 * 64 + lane) * 8;
      f32x16 acc0 = zero16(), acc1 = zero16();
#pragma unroll
      for (int ks = 0; ks < 8; ++ks) {
        const bf16x8 bq = (mat == 0) ? bq0[ks] : *(const bf16x8*)(wb + ks * 512);
        acc0 = mfma32(LDS8(xcb + r * 136 + ks * 16 + hh * 8), bq, acc0);
        acc1 = mfma32(LDS8(xcb + (32 + r) * 136 + ks * 16 + hh * 8), bq, acc1);
      }
      const int ch = nq * 32 + r;
      if (mat == 0) {
#pragma unroll
        for (int i = 0; i < 16; ++i) { lav[0][i] = c8l * sigmoidf_(acc0[i] + ba); lav[1][i] = c8l * sigmoidf_(acc1[i] + ba); }
      } else {
#pragma unroll
        for (int mi = 0; mi < 2; ++mi)
#pragma unroll
          for (int g4 = 0; g4 < 4; ++g4) {
            float lq[4], uq[4];
#pragma unroll
            for (int j = 0; j < 4; ++j) {
              const int i = 4 * g4 + j;
              const int row = mi * 32 + 8 * g4 + 4 * hh + j;
              const float ig = sigmoidf_((mi ? acc1[i] : acc0[i]) + bx);
              const float la = lav[mi][i];
              lq[j] = la;
              uq[j] = __builtin_amdgcn_sqrtf(fmaxf(1.f - fexp(2.f * la), 0.f)) * (ig * xcf[row * 128 + ch]);
            }
            const int o = (dir * 128 + ch) * 68 + mi * 32 + 8 * g4 + 4 * hh;
            uint2 l2, u2;
            l2.x = pack2(lq[0], lq[1]); l2.y = pack2(lq[2], lq[3]);
            u2.x = pack2(uq[0], uq[1]); u2.y = pack2(uq[2], uq[3]);
            *(uint2*)(la_s + o) = l2;
            *(uint2*)(u_s + o) = u2;
          }
      }
    }
    __syncthreads();
    {
      const size_t tile = (size_t)(rowof(seq, t0) >> 6);
#pragma unroll
      for (int i = 0; i < 8; ++i) {
        const int cc = tid + 512 * i;
        const int arr = cc >> 10, rem = cc & 1023, chh = rem >> 3, tk = rem & 7;
        const int dirr = arr & 1, isu = arr >> 1;
        const u16* src = (isu ? u_s : la_s) + (dirr * 128 + chh) * 68 + tk * 8;
        u16* dst = (isu ? LU : LA) + (((size_t)dirr * 520 + tile) * 512 + nblk * 128 + chh) * 64 + tk * 8;
        const uint2 lo = *(const uint2*)(src), hi = *(const uint2*)(src + 4);
        *(uint4*)dst = make_uint4(lo.x, lo.y, hi.x, hi.y);
      }
    }
    if (tid < 256) {
      const int dirr = tid >> 7, ch = tid & 127;
      const u16* lp = la_s + (dirr * 128 + ch) * 68;
      const u16* up = u_s + (dirr * 128 + ch) * 68;
      float hloc = 0.f, las = 0.f;
      if (dirr == 0) {
#pragma unroll
        for (int q = 0; q < 16; ++q) {
          const uint2 l2 = *(const uint2*)(lp + q * 4), u2 = *(const uint2*)(up + q * 4);
          const float lf[4] = {lo2f(l2.x), hi2f(l2.x), lo2f(l2.y), hi2f(l2.y)};
          const float uf[4] = {lo2f(u2.x), hi2f(u2.x), lo2f(u2.y), hi2f(u2.y)};
#pragma unroll
          for (int j = 0; j < 4; ++j) { hloc = fexp(lf[j]) * hloc + uf[j]; las += lf[j]; }
        }
      } else {
#pragma unroll
        for (int q = 15; q >= 0; --q) {
          const uint2 l2 = *(const uint2*)(lp + q * 4), u2 = *(const uint2*)(up + q * 4);
          const float lf[4] = {lo2f(l2.x), hi2f(l2.x), lo2f(l2.y), hi2f(l2.y)};
          const float uf[4] = {lo2f(u2.x), hi2f(u2.x), lo2f(u2.y), hi2f(u2.y)};
#pragma unroll
          for (int j = 3; j >= 0; --j) { hloc = fexp(lf[j]) * hloc + uf[j]; las += lf[j]; }
        }
      }
      if (dirr == 0) Uacc = fexp(las) * Uacc + hloc;
      else Uacc = Uacc + fexp(LAacc) * hloc;
      LAacc += las;
    }
    __syncthreads();
  }
  if (tid0 < 256) {
    const int dirr = tid0 >> 7, ch = tid0 & 127;
    const int pidx = dirr == 0 ? sidx : (sidx < 2 ? 1 - sidx : 131 - sidx);
    const size_t idx = ((size_t)(dirr * 2 + b) * 130 + pidx) * 512 + nblk * 128 + ch;
    LSA[idx] = LAacc;
    LSU[idx] = Uacc;
  }
}

__device__ __forceinline__ void lru_final_item(const P& p, int b, int sidx) {
  const int ch = opq_tid();
  const u16* Z = (const u16*)(p.ws + OFF_Z);
  u16* Y = (u16*)(p.ws + OFF_HY);
  const u16* LA = (const u16*)(p.ws + OFF_LA);
  const u16* LU = (const u16*)(p.ws + OFF_LU);
  const float* LSU = (const float*)(p.ws + OFF_LSU);
  int seq, tbase;
  if (sidx < 2) { seq = 2 + b; tbase = sidx * 128; }
  else { seq = b; tbase = (sidx - 2) * 128; }
  const int grow0 = rowof(seq, tbase);
  const size_t tile0 = (size_t)(grow0 >> 6);
  const int p_fw = sidx, p_bw = sidx < 2 ? 1 - sidx : 131 - sidx;
  unsigned hbp[64];
  {
    float h = LSU[((size_t)(2 + b) * 130 + p_bw) * 512 + ch];
#pragma unroll
    for (int tl = 1; tl >= 0; --tl) {
      const uint4* lp = (const uint4*)(LA + (((size_t)520 + tile0 + tl) * 512 + ch) * 64);
      const uint4* up = (const uint4*)(LU + (((size_t)520 + tile0 + tl) * 512 + ch) * 64);
      uint4 lv[8], uv[8];
#pragma unroll
      for (int q = 0; q < 8; ++q) { lv[q] = lp[q]; uv[q] = up[q]; }
#pragma unroll
      for (int q = 7; q >= 0; --q) {
        float lf[8], uf[8];
        unpack8(lv[q], lf);
        unpack8(uv[q], uf);
#pragma unroll
        for (int j = 7; j >= 0; j -= 2) {
          h = fexp(lf[j]) * h + uf[j];
          const float h1 = h;
          h = fexp(lf[j - 1]) * h + uf[j - 1];
          hbp[(tl * 64 + q * 8 + j) >> 1] = pack2(h, h1);
        }
      }
    }
  }
  {
    float h = LSU[((size_t)(b) * 130 + p_fw) * 512 + ch];
    const u16* gp = Z + (size_t)grow0 * ZW + 2080 + ch;
    u16* yp = Y + (size_t)grow0 * 1024 + 512 + ch;
#pragma unroll
    for (int tl = 0; tl < 2; ++tl) {
      const uint4* lp = (const uint4*)(LA + ((tile0 + tl) * 512 + ch) * 64);
      const uint4* up = (const uint4*)(LU + ((tile0 + tl) * 512 + ch) * 64);
      uint4 lv[8], uv[8];
#pragma unroll
      for (int q = 0; q < 8; ++q) { lv[q] = lp[q]; uv[q] = up[q]; }
#pragma unroll
      for (int q = 0; q < 8; ++q) {
        float lf[8], uf[8];
        unpack8(lv[q], lf);
        unpack8(uv[q], uf);
        u16 g[8];
#pragma unroll
        for (int j = 0; j < 8; ++j) g[j] = gp[(size_t)(tl * 64 + q * 8 + j) * ZW];
#pragma unroll
        for (int j = 0; j < 8; ++j) {
          const int t = tl * 64 + q * 8 + j;
          h = fexp(lf[j]) * h + uf[j];
          const unsigned hp = hbp[t >> 1];
          const float hb = (t & 1) ? hi2f(hp) : lo2f(hp);
          yp[(size_t)t * 1024] = f2bf((h + hb) * siluf_(bf2f(g[j])));
        }
      }
    }
  }
}

__device__ __forceinline__ void attn_item(const P& p, int jl, bool isctx, int b, int qb, int kvh, char* lds) {
  const int tid = opq_tid(), lane = tid & 63, w = tid >> 6, r = lane & 31, hh = lane >> 5;
  u16* K_s = (u16*)(lds);
  u16* V_s = (u16*)(lds + 9216);
  u16* Pw = (u16*)(lds + 21504) + w * 64 * 72;
  const int trv = tr_lane_off(lane, 96);
  const u16* Z = (const u16*)(p.ws + OFF_Z);
  u16* Y = (u16*)(p.ws + OFF_HY);
  const int g = w >> 1, half = w & 1, qh = kvh * 4 + g;
  const int qseq = isctx ? 2 + b : b;
  const int t0 = qb * 128;
  bf16x8 qf[2][4];
#pragma unroll
  for (int n = 0; n < 2; ++n) {
    const int qrow = rowof(qseq, t0 + half * 64 + n * 32 + r);
#pragma unroll
    for (int ks = 0; ks < 4; ++ks) qf[n][ks] = *(const bf16x8*)(Z + (size_t)qrow * ZW + qh * 64 + ks * 16 + hh * 8);
  }
  const float sink = p.in[27][jl * 8 + qh];
  float m[2] = {sink, sink};
  float l[2] = {hh == 0 ? 1.f : 0.f, hh == 0 ? 1.f : 0.f};
  f32x16 accO[2][2];
#pragma unroll
  for (int a = 0; a < 2; ++a)
#pragma unroll
    for (int n = 0; n < 2; ++n) accO[a][n] = zero16();
  int ilo = 0, ihi = 0;
  if (!isctx) { ilo = t0 >= 128 ? 0 : 2; ihi = (t0 + 256 <= L) ? 6 : 4; }
  const int nlat = ihi - ilo, ntiles = nlat + 4;
  const int tqlo = t0 + half * 64;
  uint4 kvr, vvr;
  auto issue_kv = [&](int j) {
    const int key = tid >> 3, c8 = (tid & 7) * 8;
    const int row = (j < nlat) ? rowof(b, t0 - 128 + 64 * (ilo + j) + key) : rowof(2 + b, (j - nlat) * 64 + key);
    const u16* zr = Z + (size_t)row * ZW;
    kvr = *(const uint4*)(zr + 512 + kvh * 64 + c8);
    vvr = *(const uint4*)(zr + 640 + kvh * 64 + c8);
  };
  issue_kv(0);
  for (int ti = 0; ti < ntiles; ++ti) {
    const bool lat = ti < nlat;
    const int kt = lat ? t0 - 128 + 64 * (ilo + ti) : (ti - nlat) * 64;
    const bool skip = lat && (kt - (tqlo + 63) > 128 || kt + 63 - tqlo < -128);
    const bool masked = lat && (kt + 63 - tqlo > 128 || kt - (tqlo + 63) < -128);
    {
      const int key = tid >> 3, c8 = (tid & 7) * 8;
      *(uint4*)(K_s + key * 72 + c8) = kvr;
      *(uint4*)(V_s + key * 96 + c8) = vvr;
    }
    if (ti + 1 < ntiles) issue_kv(ti + 1);
    __syncthreads();
    if (!skip) {
    f32x16 s[2][2];
#pragma unroll
    for (int a = 0; a < 2; ++a)
#pragma unroll
      for (int n = 0; n < 2; ++n) s[a][n] = zero16();
#pragma unroll
    for (int ks = 0; ks < 4; ++ks) {
      const bf16x8 a0 = LDS8(K_s + r * 72 + ks * 16 + hh * 8);
      const bf16x8 a1 = LDS8(K_s + (32 + r) * 72 + ks * 16 + hh * 8);
      s[0][0] = mfma32(a0, qf[0][ks], s[0][0]);
      s[0][1] = mfma32(a0, qf[1][ks], s[0][1]);
      s[1][0] = mfma32(a1, qf[0][ks], s[1][0]);
      s[1][1] = mfma32(a1, qf[1][ks], s[1][1]);
    }
    if (masked) {
#pragma unroll
      for (int mk = 0; mk < 2; ++mk)
#pragma unroll
        for (int n = 0; n < 2; ++n)
#pragma unroll
          for (int i = 0; i < 16; ++i) {
            const int kp = kt + mk * 32 + 8 * (i >> 2) + 4 * hh + (i & 3);
            const int dl = kp - (tqlo + n * 32 + r);
            if (dl > 128 || dl < -128) s[mk][n][i] = -1e30f;
          }
    }
#pragma unroll
    for (int n = 0; n < 2; ++n) {
      float mx = -1e30f;
#pragma unroll
      for (int mk = 0; mk < 2; ++mk)
#pragma unroll
        for (int i = 0; i < 16; ++i) mx = fmaxf(mx, s[mk][n][i]);
      mx = fmaxf(mx, __shfl_xor(mx, 32));
      const float mn = fmaxf(m[n], mx);
      const float alpha = fexp(m[n] - mn);
      m[n] = mn;
      float ls = 0.f;
#pragma unroll
      for (int mk = 0; mk < 2; ++mk)
#pragma unroll
        for (int i = 0; i < 16; ++i) {
          const float pv = fexp(s[mk][n][i] - mn);
          s[mk][n][i] = pv;
          ls += pv;
        }
      l[n] = l[n] * alpha + ls;
#pragma unroll
      for (int mv = 0; mv < 2; ++mv)
#pragma unroll
        for (int i = 0; i < 16; ++i) accO[mv][n][i] *= alpha;
#pragma unroll
      for (int mk = 0; mk < 2; ++mk)
#pragma unroll
        for (int g4 = 0; g4 < 4; ++g4) {
          uint2 s2;
          s2.x = pack2(s[mk][n][4 * g4], s[mk][n][4 * g4 + 1]);
          s2.y = pack2(s[mk][n][4 * g4 + 2], s[mk][n][4 * g4 + 3]);
          *(uint2*)(Pw + (n * 32 + r) * 72 + mk * 32 + 8 * g4 + 4 * hh) = s2;
        }
    }
    }
    __syncthreads();
    if (!skip) {
#pragma unroll
    for (int ks = 0; ks < 4; ++ks) {
      const bf16x8 b0 = LDS8(Pw + r * 72 + ks * 16 + hh * 8);
      const bf16x8 b1 = LDS8(Pw + (32 + r) * 72 + ks * 16 + hh * 8);
      const bf16x8 a0 = tr_frag(V_s, 96, ks, 0, trv);
      const bf16x8 a1 = tr_frag(V_s, 96, ks, 1, trv);
      accO[0][0] = mfma32(a0, b0, accO[0][0]);
      accO[0][1] = mfma32(a0, b1, accO[0][1]);
      accO[1][0] = mfma32(a1, b0, accO[1][0]);
      accO[1][1] = mfma32(a1, b1, accO[1][1]);
    }
    }
    __syncthreads();
  }
#pragma unroll
  for (int n = 0; n < 2; ++n) {
    const float lt = l[n] + __shfl_xor(l[n], 32);
    const float inv = __builtin_amdgcn_rcpf(lt);
    const int qrow = rowof(qseq, t0 + half * 64 + n * 32 + r);
    const u16* gp = Z + (size_t)qrow * ZW + 768 + qh * 64;
    u16* yp = Y + (size_t)qrow * 1024 + qh * 64;
#pragma unroll
    for (int mv = 0; mv < 2; ++mv)
#pragma unroll
      for (int g4 = 0; g4 < 4; ++g4) {
        const int v0 = mv * 32 + 8 * g4 + 4 * hh;
        const uint2 gv = *(const uint2*)(gp + v0);
        const float o0 = accO[mv][n][4 * g4] * inv * siluf_(lo2f(gv.x));
        const float o1 = accO[mv][n][4 * g4 + 1] * inv * siluf_(hi2f(gv.x));
        const float o2 = accO[mv][n][4 * g4 + 2] * inv * siluf_(lo2f(gv.y));
        const float o3 = accO[mv][n][4 * g4 + 3] * inv * siluf_(hi2f(gv.y));
        uint2 ov;
        ov.x = pack2(o0, o1); ov.y = pack2(o2, o3);
        *(uint2*)(yp + v0) = ov;
      }
  }
}

__device__ __forceinline__ void make_cfg(const P& p, int l, MixCfg& c) {
  const int jl = l >> 1;
  if ((l & 1) == 0) {
    c.qcol = 0; c.kcol = 256; c.vcol = 512; c.gcol = 1024; c.ycol = 0; c.lrcol = 1536; c.ret = 0; c.pad = 0;
    c.up0 = p.in[8] + jl * 16 * 256; c.up1 = p.in[10] + jl * 16 * 256;
    c.ub0 = p.in[9] + jl * 256; c.ub1 = p.in[11] + jl * 256;
    c.dec0 = p.in[28]; c.dec1 = p.in[29];
    c.ng = p.in[12] + jl * 128;
  } else {
    c.qcol = 1280; c.kcol = 1536; c.vcol = 1792; c.gcol = 2304; c.ycol = 512; c.lrcol = 0; c.ret = 1; c.pad = 0;
    c.up0 = p.in[8]; c.up1 = p.in[10];
    c.ub0 = p.in[9]; c.ub1 = p.in[11];
    c.dec0 = p.in[28] + jl * 4; c.dec1 = p.in[29] + jl * 4;
    c.ng = p.in[30] + jl * 128;
  }
}

__device__ __forceinline__ void phase_mix1(const P& p, int l, char* lds) {
  MixCfg c;
  make_cfg(p, l, c);
  const int jl = l >> 1;
  const bool odd = (l & 1) != 0;
  const int G = gridDim.x;
  if (odd) {
    for (int rp = 0; rp < ((PROBE_REP & 0x100) ? 2 : 1); ++rp)
    for (int it = blockIdx.x; it < 512; it += G) attn_item(p, jl, false, it >> 8, (it >> 1) & 127, it & 1, lds);
  } else {
    const int vb = (blockIdx.x + G - 16) % G;
    for (int rp = 0; rp < ((PROBE_REP & 0x200) ? 2 : 1); ++rp)
    for (int it = vb; it < 1040; it += G) {
      int bb, sidx, nblk;
      if (it < 1024) { nblk = it & 3; sidx = 2 + ((it >> 2) & 127); bb = it >> 9; }
      else { const int j = it - 1024; nblk = j & 3; sidx = (j >> 2) & 1; bb = j >> 3; }
      lru_coeff_item(p, jl, bb, sidx, nblk, lds);
    }
  }
  {
    const int vb = (blockIdx.x + G - 40) % G;
    for (int rp = 0; rp < ((PROBE_REP & 0x400) ? 2 : 1); ++rp)
    for (int it = vb; it < 552; it += G) {
      if (it < 512) {
        const int seg = it & 63, rest = it >> 6;
        gla_passA(p, c, rest >> 2, rest & 3, rest >> 2, seg * 256, seg + 1, 64 - seg, lds);
      } else if (it < 520) {
        const int j = it - 512;
        gla_passA(p, c, j >> 2, j & 3, 2 + (j >> 2), 0, 0, 0, lds);
      } else {
        const int j = it - 520, k = j & 3, bh = j >> 2;
        gla_dir_pass(p, c, bh >> 2, bh & 3, 1, 0, lds, true, false, k + 1, k, false);
      }
    }
  }
}

__device__ __forceinline__ void phase_scan(const P& p, int l, char* lds) {
  float* GS = (float*)(p.ws + OFF_GS);
  const float* GD = (const float*)(p.ws + OFF_GD);
  const int tid = opq_tid();
  for (int gidx = blockIdx.x * 512 + tid; gidx < 16 * 8192; gidx += gridDim.x * 512) {
    const int combo = gidx >> 13, e = gidx & 8191;
    float* gs = GS + (size_t)combo * 65 * 8192 + e;
    const float* gd = GD + (size_t)combo * 65 * 64 + (e >> 7);
    float S = 0.f;
#pragma unroll 1
    for (int q0 = 0; q0 < 65; q0 += 13) {
      float ev[13], dd[13];
#pragma unroll
      for (int q = 0; q < 13; ++q) { ev[q] = gs[(size_t)(q0 + q) * 8192]; dd[q] = gd[(q0 + q) * 64]; }
#pragma unroll
      for (int q = 0; q < 13; ++q) {
        gs[(size_t)(q0 + q) * 8192] = S;
        S = dd[q] * S + ev[q];
      }
    }
  }
  if ((l & 1) == 0) {
    const float* LSA = (const float*)(p.ws + OFF_LSA);
    float* LSU = (float*)(p.ws + OFF_LSU);
    for (int gidx = blockIdx.x * 512 + tid; gidx < 2048; gidx += gridDim.x * 512) {
      const int combo = gidx >> 9, ch = gidx & 511;
      const float* pa = LSA + (size_t)combo * 130 * 512 + ch;
      float* pu = LSU + (size_t)combo * 130 * 512 + ch;
      float hin = 0.f;
#pragma unroll 1
      for (int q0 = 0; q0 < 130; q0 += 13) {
        float la[13], u[13];
#pragma unroll
        for (int q = 0; q < 13; ++q) { la[q] = pa[(q0 + q) * 512]; u[q] = pu[(q0 + q) * 512]; }
#pragma unroll
        for (int q = 0; q < 13; ++q) {
          pu[(q0 + q) * 512] = hin;
          hin = fexp(la[q]) * hin + u[q];
        }
      }
    }
  }
  {
    MixCfg c;
    make_cfg(p, l, c);
    const int G = gridDim.x;
    const int vb = (blockIdx.x + G - 64) % G;
    for (int it = vb; it < 32; it += G) {
      const int k = it & 3, bh = it >> 2;
      gla_dir_pass(p, c, bh >> 2, bh & 3, 0, 0, lds, true, true, k + 1, k, false);
    }
    if (l & 1) {
      const int vb2 = (blockIdx.x + G - 128) % G;
      for (int it = vb2; it < 8; it += G) attn_item(p, l >> 1, true, it >> 2, (it >> 1) & 1, it & 1, lds);
    }
  }
}

__device__ __forceinline__ void phase_mix2(const P& p, int l, char* lds) {
  MixCfg c;
  make_cfg(p, l, c);
  const bool odd = (l & 1) != 0;
  const int G = gridDim.x;
  for (int rp = 0; rp < ((PROBE_REP & 0x800) ? 2 : 1); ++rp)
  for (int it = blockIdx.x; it < 512; it += G) {
    const int sidx = 1 + (it & 63), rest = it >> 6;
    const int h = rest & 3, b = rest >> 2;
    for (int dd = 1; dd >= 0; --dd) gla_dir_pass(p, c, b, h, dd, dd ? 65 - sidx : sidx, lds, true, dd == 0, 4, 0, false);
  }
  if (!odd) {
    const int vb = (blockIdx.x + G - 64) % G;
    for (int it = vb; it < 260; it += G) {
      if (it < 256) lru_final_item(p, it >> 7, 2 + (it & 127));
      else lru_final_item(p, (it - 256) >> 1, (it - 256) & 1);
    }
  }
}

__device__ __forceinline__ void grid_barrier(unsigned* ctr, unsigned target) {
  asm volatile("s_waitcnt vmcnt(0)" ::: "memory");
  __syncthreads();
  if (threadIdx.x == 0) {
    __builtin_amdgcn_fence(__ATOMIC_RELEASE, "agent");
    asm volatile("s_waitcnt vmcnt(0)" ::: "memory");
    __hip_atomic_fetch_add(ctr, 1u, __ATOMIC_RELAXED, __HIP_MEMORY_SCOPE_AGENT);
    unsigned sp = 0;
    while (__hip_atomic_load(ctr, __ATOMIC_RELAXED, __HIP_MEMORY_SCOPE_AGENT) < target) {
      __builtin_amdgcn_s_sleep(1);
      if (++sp > (1u << 24)) break;
    }
    __builtin_amdgcn_fence(__ATOMIC_ACQUIRE, "agent");
    asm volatile("s_waitcnt vmcnt(0)" ::: "memory");
  }
  __syncthreads();
}

__global__ void __launch_bounds__(512) fwd_megakernel(P p) {
  extern __shared__ __attribute__((aligned(16))) char lds[];
  const int ph_lo = p.ph_lo, ph_hi = p.ph_hi;
  unsigned nbar = 0;
  unsigned* bar_ctr = (unsigned*)(p.ws + OFF_BAR);
  for (int i = 0; i < PROBE_SYNC; ++i) { ++nbar; grid_barrier(bar_ctr, nbar * gridDim.x); }
  for (int ph = ph_lo; ph < ph_hi; ++ph) {
    int reps = 1;
    if (PROBE_REP) {
      const int l = (ph - 1) / 6, s = (ph - 1) % 6;
      if (ph == 0) { if (PROBE_REP & 64) reps = 2; }
      else if (ph < NPH - 1 && s != 3 && (s != 5 || l == 0) && ((PROBE_REP >> s) & 1)) reps = 2;
    }
    for (int rep = 0; rep < reps; ++rep) {
    if (ph > ph_lo || rep > 0) {
      if (ph == ph_lo + 1 && rep == 0) cg::this_grid().sync();
      else { ++nbar; grid_barrier(bar_ctr, nbar * gridDim.x); }
    }
    size_t z = 0;
    asm volatile("" : "+s"(z));
    const P& q = *(const P*)((const __attribute__((address_space(4))) char*)__builtin_amdgcn_kernarg_segment_ptr() + z);
    char* ldsq = lds + z;
    if (ph == 0) phase_prep(q, ldsq);
    else if (ph == NPH - 1) phase_final(q);
    else {
      const int l = (ph - 1) / 6, s = (ph - 1) % 6;
      if (s == 0) phase_norm(q, l);
      else if (s == 1) phase_gemm_in(q, l, ldsq);
      else if (s == 2) phase_mix1(q, l, ldsq);
      else if (s == 3) phase_scan(q, l, ldsq);
      else if (s == 4) phase_mix2(q, l, ldsq);
      else phase_gemm_out(q, l, ldsq);
    }
    }
  }
}

extern "C" void kernel_launch(void* const* d_in, const int* in_sizes, int n_in, void* d_out, int out_size,
                              void* d_ws, size_t ws_size, hipStream_t stream) {
  static int grid = 0;
  if (grid == 0) {
    if (n_in != 33 || ws_size < WS_END) {
      fprintf(stderr, "kernel_launch: unexpected n_in %d or ws_size %zu (< %zu)\n", n_in, ws_size, (size_t)WS_END);
      grid = -1;
      return;
    }
    int dev = 0, cus = 0;
    hipGetDevice(&dev);
    hipDeviceGetAttribute(&cus, hipDeviceAttributeMultiprocessorCount, dev);
    if (hipFuncSetAttribute((const void*)fwd_megakernel, hipFuncAttributeMaxDynamicSharedMemorySize, LDS_BYTES) != hipSuccess) {
      fprintf(stderr, "kernel_launch: hipFuncSetAttribute failed\n");
      grid = -1;
      return;
    }
    int per_cu = 0;
    hipOccupancyMaxActiveBlocksPerMultiprocessor(&per_cu, (const void*)fwd_megakernel, 512, LDS_BYTES);
    (void)hipGetLastError();
    if (per_cu < 1) fprintf(stderr, "kernel_launch: occupancy query says %d blocks per CU\n", per_cu);
    grid = cus > 0 ? cus : 256;
  }
  if (grid < 0) return;
  P p{};
  for (int i = 0; i < 33; ++i) p.in[i] = (const float*)d_in[i];
  p.out = (float*)d_out;
  p.ws = (char*)d_ws;
#if MK_COOP
  if (hipMemsetAsync((char*)d_ws + OFF_BAR, 0, 256, stream) != hipSuccess) { fprintf(stderr, "kernel_launch: memset of barrier words failed\n"); return; }
  p.ph_lo = 0; p.ph_hi = NPH;
  void* args[] = {&p};
  hipError_t e = hipLaunchCooperativeKernel((const void*)fwd_megakernel, dim3(grid), dim3(512), args, LDS_BYTES, stream);
  if (e != hipSuccess) fprintf(stderr, "cooperative launch failed: %s (grid %d)\n", hipGetErrorString(e), grid);
#else
  for (int ph = 0; ph < NPH; ++ph) {
    p.ph_lo = ph; p.ph_hi = ph + 1;
    hipLaunchKernelGGL(fwd_megakernel, dim3(grid), dim3(512), LDS_BYTES, stream, p);
  }
#endif
}
```

```cpp
#include <hip/hip_runtime.h>
#include <hip/hip_cooperative_groups.h>
#include <cstdio>
namespace cg = cooperative_groups;

#ifndef MK_COOP
#define MK_COOP 1
#endif
#ifndef PROBE_REP
#define PROBE_REP 0
#endif
#ifndef PROBE_SYNC
#define PROBE_SYNC 0
#endif

typedef unsigned short u16;
typedef __attribute__((ext_vector_type(8))) short bf16x8;
typedef __attribute__((ext_vector_type(16))) float f32x16;

constexpr int D = 1024, NB = 2, L = 16384, LC = 256;
constexpr int NLAT = NB * L, NCTX = NB * LC, NROW = NLAT + NCTX;
constexpr int ZW = 2816;
constexpr int NPH = 26;
constexpr int LDS_BYTES = 163840;

constexpr size_t OFF_Z    = 0;
constexpr size_t OFF_HY   = OFF_Z + (size_t)NROW * ZW * 2;
constexpr size_t OFF_WIN  = OFF_HY + (size_t)NROW * 1024 * 2;
constexpr size_t OFF_WOUT = OFF_WIN + (size_t)4 * 2816 * 1024 * 2;
constexpr size_t OFF_WLRU = OFF_WOUT + (size_t)4 * 1024 * 1024 * 2;
constexpr size_t OFF_LA   = OFF_WLRU + (size_t)2 * 4 * 4 * 16384 * 2;
constexpr size_t OFF_LU   = OFF_LA + (size_t)2 * NROW * 512 * 2;
constexpr size_t OFF_GS   = OFF_LU + (size_t)2 * NROW * 512 * 2;
constexpr size_t OFF_GD   = OFF_GS + (size_t)16 * 65 * 8192 * 4;
constexpr size_t OFF_LSA  = OFF_GD + (size_t)16 * 65 * 64 * 4;
constexpr size_t OFF_LSU  = OFF_LSA + (size_t)4 * 130 * 512 * 4;
constexpr size_t OFF_MOD  = OFF_LSU + (size_t)4 * 130 * 512 * 4;
constexpr size_t OFF_CTXX = OFF_MOD + (size_t)4 * 3 * 3072 * 4;
constexpr size_t OFF_ROPE = OFF_CTXX + (size_t)NCTX * 1024 * 4;
constexpr size_t OFF_BAR  = OFF_ROPE + (size_t)256 * 16 * 8;
constexpr size_t WS_END   = OFF_BAR + 256;

struct P {
  const float* in[33];
  float* out;
  char* ws;
  int ph_lo, ph_hi;
};

struct MixCfg {
  int qcol, kcol, vcol, gcol, ycol, lrcol, ret, pad;
  const float* up0; const float* up1;
  const float* ub0; const float* ub1;
  const float* dec0; const float* dec1;
  const float* ng;
};

typedef __attribute__((ext_vector_type(2))) float f32x2_t;
typedef __attribute__((ext_vector_type(2))) __bf16 bf16x2_t;
__device__ __forceinline__ unsigned pack2(float a, float b) {
  f32x2_t f; f[0] = a; f[1] = b;
  return __builtin_bit_cast(unsigned, __builtin_convertvector(f, bf16x2_t));
}
__device__ __forceinline__ u16 f2bf(float f) { return (u16)(pack2(f, 0.f) & 0xffffu); }
__device__ __forceinline__ float bf2f(u16 h) { return __uint_as_float(((unsigned)h) << 16); }
__device__ __forceinline__ float lo2f(unsigned u) { return __uint_as_float(u << 16); }
__device__ __forceinline__ float hi2f(unsigned u) { return __uint_as_float(u & 0xffff0000u); }
__device__ __forceinline__ void unpack8(const uint4& v, float* f) {
  f[0] = lo2f(v.x); f[1] = hi2f(v.x); f[2] = lo2f(v.y); f[3] = hi2f(v.y);
  f[4] = lo2f(v.z); f[5] = hi2f(v.z); f[6] = lo2f(v.w); f[7] = hi2f(v.w);
}
__device__ __forceinline__ uint4 pack8(const float* f) {
  uint4 v; v.x = pack2(f[0], f[1]); v.y = pack2(f[2], f[3]); v.z = pack2(f[4], f[5]); v.w = pack2(f[6], f[7]); return v;
}
__device__ __forceinline__ int opq_tid() { int t = threadIdx.x; asm volatile("" : "+v"(t)); return t; }
__device__ __forceinline__ float fexp(float x) { return __builtin_amdgcn_exp2f(x * 1.4426950408889634f); }
__device__ __forceinline__ float flog(float x) { return __builtin_amdgcn_logf(x) * 0.6931471805599453f; }
__device__ __forceinline__ float sigmoidf_(float x) { return __builtin_amdgcn_rcpf(1.f + fexp(-x)); }
__device__ __forceinline__ float siluf_(float x) { return x * __builtin_amdgcn_rcpf(1.f + fexp(-x)); }
__device__ __forceinline__ float logsigf_(float x) { return fminf(x, 0.f) - flog(1.f + fexp(-fabsf(x))); }
__device__ __forceinline__ int rowof(int seq, int t) { return seq < 2 ? seq * L + t : NLAT + (seq - 2) * LC + t; }
__device__ __forceinline__ f32x16 mfma32(bf16x8 a, bf16x8 b, f32x16 c) {
  return __builtin_amdgcn_mfma_f32_32x32x16_bf16(a, b, c, 0, 0, 0);
}
typedef __attribute__((ext_vector_type(4))) float f32x4;
__device__ __forceinline__ f32x4 mfma16(bf16x8 a, bf16x8 b, f32x4 c) {
  return __builtin_amdgcn_mfma_f32_16x16x32_bf16(a, b, c, 0, 0, 0);
}
__device__ __forceinline__ f32x16 zero16() {
  f32x16 z;
#pragma unroll
  for (int i = 0; i < 16; ++i) z[i] = 0.f;
  return z;
}
#define LDS8(ptr) (*(const bf16x8*)(ptr))
typedef __attribute__((ext_vector_type(4))) short s16x4;
__device__ __forceinline__ int tr_lane_off(int lane, int stride) {
  return (8 * (lane >> 5) + ((lane & 15) >> 2)) * stride + 16 * ((lane >> 4) & 1) + 4 * (lane & 3);
}
__device__ __forceinline__ bf16x8 tr_frag(const u16* T, int stride, int ks, int c, int loff) {
  const u16* a0 = T + loff + 16 * ks * stride + 32 * c;
  const s16x4 lo = __builtin_amdgcn_ds_read_tr16_b64_v4i16((__attribute__((address_space(3))) s16x4*)(a0));
  const s16x4 hi = __builtin_amdgcn_ds_read_tr16_b64_v4i16((__attribute__((address_space(3))) s16x4*)(a0 + 4 * stride));
  bf16x8 f;
  f[0] = lo[0]; f[1] = lo[1]; f[2] = lo[2]; f[3] = lo[3]; f[4] = hi[0]; f[5] = hi[1]; f[6] = hi[2]; f[7] = hi[3];
  return f;
}

__device__ __forceinline__ void transpose_tile(const float* __restrict__ src, int ldsrc, int nvalid, int n0, int k0,
                               u16* __restrict__ dst, int lddst, int scale_mode, char* lds) {
  float* ts = (float*)lds;
  const int tid = opq_tid();
  {
    const int k = tid >> 3, n8 = (tid & 7) * 8;
    float v[8];
    if (n0 + n8 < nvalid) {
      const float4 a = *(const float4*)(src + (size_t)(k0 + k) * ldsrc + n0 + n8);
      const float4 b = *(const float4*)(src + (size_t)(k0 + k) * ldsrc + n0 + n8 + 4);
      v[0] = a.x; v[1] = a.y; v[2] = a.z; v[3] = a.w; v[4] = b.x; v[5] = b.y; v[6] = b.z; v[7] = b.w;
    } else {
#pragma unroll
      for (int j = 0; j < 8; ++j) v[j] = 0.f;
    }
#pragma unroll
    for (int j = 0; j < 8; ++j) {
      const int n = n0 + n8 + j;
      float x = v[j];
      if (scale_mode == 1) { if (n < 256) x *= 0.125f; }
      else if (scale_mode == 2) { if (n < 512 || (n >= 1536 && n < 1792)) x *= 0.125f; }
      ts[k * 65 + n8 + j] = x;
    }
  }
  __syncthreads();
  {
    const int n = tid >> 3, k8 = (tid & 7) * 8;
    float f[8];
#pragma unroll
    for (int j = 0; j < 8; ++j) f[j] = ts[(k8 + j) * 65 + n];
    if (lddst > 0) *(uint4*)(dst + (size_t)(n0 + n) * lddst + k0 + k8) = pack8(f);
    else {
      const int jj = n0 + n, ii = k0 + k8;
      *(uint4*)(dst + ((((jj >> 5) * 8 + (ii >> 4)) * 64 + (jj & 31) + 32 * ((ii >> 3) & 1)) * 8)) = pack8(f);
    }
  }
  __syncthreads();
}

__device__ __forceinline__ void phase_prep(const P& p, char* lds) {
  const int tid = opq_tid();
  constexpr int T_WIN = 4 * 44 * 16, T_WOUT = 4 * 16 * 16, T_LRU = 2 * 4 * 4 * 4, T_MOD = 96;
  constexpr int TOT = T_WIN + T_WOUT + T_LRU + T_MOD + 1;
  for (int it = blockIdx.x; it < TOT; it += gridDim.x) {
    if (it < T_WIN) {
      const int l = it / 704, rem = it % 704, ntile = rem >> 4, ktile = rem & 15;
      const bool even = (l & 1) == 0;
      const float* src = even ? p.in[7] + (size_t)(l >> 1) * 1024 * 2592 : p.in[26] + (size_t)(l >> 1) * 1024 * 2816;
      transpose_tile(src, even ? 2592 : 2816, even ? 2592 : 2816, ntile * 64, ktile * 64,
                     (u16*)(p.ws + OFF_WIN) + (size_t)l * 2816 * 1024, 1024, even ? 1 : 2, lds);
    } else if (it < T_WIN + T_WOUT) {
      const int j = it - T_WIN, l = j >> 8, rem = j & 255, ntile = rem >> 4, ktile = rem & 15;
      const float* src = ((l & 1) == 0) ? p.in[25] + (size_t)(l >> 1) * 1024 * 1024 : p.in[31] + (size_t)(l >> 1) * 1024 * 1024;
      transpose_tile(src, 1024, 1024, ntile * 64, ktile * 64, (u16*)(p.ws + OFF_WOUT) + (size_t)l * 1024 * 1024, 1024, 0, lds);
    } else if (it < T_WIN + T_WOUT + T_LRU) {
      const int j = it - T_WIN - T_WOUT;
      const int t4 = j & 3, blk = (j >> 2) & 3, mat = (j >> 4) & 3, jl = j >> 6;
      const float* srcb = mat == 0 ? p.in[15] : mat == 1 ? p.in[17] : mat == 2 ? p.in[20] : p.in[22];
      const float* src = srcb + (size_t)(jl * 4 + blk) * 16384;
      u16* dst = (u16*)(p.ws + OFF_WLRU) + (size_t)((jl * 4 + mat) * 4 + blk) * 16384;
      transpose_tile(src, 128, 128, (t4 >> 1) * 64, (t4 & 1) * 64, dst, -1, 0, lds);
    } else if (it < T_WIN + T_WOUT + T_LRU + T_MOD) {
      const int j = it - T_WIN - T_WOUT - T_LRU;
      const int l = j / 24, n0 = (j % 24) * 128;
      float* sc = (float*)lds;
      float* red = (float*)(lds + 12288);
      for (int i = tid; i < 3072; i += 512) {
        const int m = i >> 10, k = i & 1023;
        const float cv = m < 2 ? p.in[1][m * 1024 + k] : p.in[3][k];
        sc[i] = siluf_(cv);
      }
      __syncthreads();
      const int cg4 = tid & 31, ks = tid >> 5;
      float acc[3][4];
#pragma unroll
      for (int m = 0; m < 3; ++m)
#pragma unroll
        for (int q = 0; q < 4; ++q) acc[m][q] = 0.f;
      const float* wp = p.in[4] + (size_t)l * 1024 * 3072 + n0 + cg4 * 4;
#pragma unroll 8
      for (int kk = 0; kk < 64; ++kk) {
        const int k = ks * 64 + kk;
        const float4 wv = *(const float4*)(wp + (size_t)k * 3072);
#pragma unroll
        for (int m = 0; m < 3; ++m) {
          const float s = sc[m * 1024 + k];
          acc[m][0] += s * wv.x; acc[m][1] += s * wv.y; acc[m][2] += s * wv.z; acc[m][3] += s * wv.w;
        }
      }
#pragma unroll
      for (int m = 0; m < 3; ++m)
#pragma unroll
        for (int q = 0; q < 4; ++q) red[(ks * 3 + m) * 128 + cg4 * 4 + q] = acc[m][q];
      __syncthreads();
      if (tid < 384) {
        const int m = tid >> 7, n = tid & 127;
        float s = 0.f;
        for (int k2 = 0; k2 < 16; ++k2) s += red[(k2 * 3 + m) * 128 + n];
        ((float*)(p.ws + OFF_MOD))[(l * 3 + m) * 3072 + n0 + n] = s + p.in[5][l * 3072 + n0 + n];
      }
      __syncthreads();
    } else {
      float2* rt = (float2*)(p.ws + OFF_ROPE);
      for (int i = tid; i < 4096; i += 512) {
        const int pos = i >> 4, f = i & 15;
        const float inv = powf(10000.f, -(float)f / 16.f);
        const float ang = (float)pos * inv;
        float s, c;
        sincosf(ang, &s, &c);
        rt[i] = make_float2(c, s);
      }
    }
  }
}

__device__ __forceinline__ const float* resid_src(const P& p, int l, int row) {
  if (row < NLAT) return (l == 0 ? p.in[0] : p.out) + (size_t)row * 1024;
  return (l == 0 ? p.in[2] : (const float*)(p.ws + OFF_CTXX)) + (size_t)(row - NLAT) * 1024;
}

__device__ __forceinline__ void phase_norm(const P& p, int l) {
  const int tid = opq_tid(), lane = tid & 63, w = tid >> 6;
  u16* H = (u16*)(p.ws + OFF_HY);
  const float* g = p.in[6] + l * 1024;
  const int stride = gridDim.x * 8;
  for (int row0 = blockIdx.x * 8 + w; row0 < NROW; row0 += 2 * stride) {
    const int row1 = row0 + stride;
    const bool has1 = row1 < NROW;
    const float* s0 = resid_src(p, l, row0);
    const float* s1 = resid_src(p, l, has1 ? row1 : row0);
    float4 v0[4], v1[4];
#pragma unroll
    for (int i = 0; i < 4; ++i) v0[i] = ((const float4*)s0)[lane + 64 * i];
#pragma unroll
    for (int i = 0; i < 4; ++i) v1[i] = ((const float4*)s1)[lane + 64 * i];
#pragma unroll
    for (int rr = 0; rr < 2; ++rr) {
      if (rr == 1 && !has1) break;
      const int row = rr ? row1 : row0;
      const int m = row < L ? 0 : (row < NLAT ? 1 : 2);
      const float* mod = (const float*)(p.ws + OFF_MOD) + (l * 3 + m) * 3072;
      float ss = 0.f;
#pragma unroll
      for (int i = 0; i < 4; ++i) {
        const float4 v = rr ? v1[i] : v0[i];
        ss += v.x * v.x + v.y * v.y + v.z * v.z + v.w * v.w;
      }
#pragma unroll
      for (int o = 32; o >= 1; o >>= 1) ss += __shfl_xor(ss, o);
      const float rstd = rsqrtf(ss * (1.f / 1024.f) + 1e-6f);
#pragma unroll
      for (int i = 0; i < 4; ++i) {
        const float4 v = rr ? v1[i] : v0[i];
        const int c = (lane + 64 * i) * 4;
        const float4 gg = *(const float4*)(g + c);
        const float4 sh = *(const float4*)(mod + c);
        const float4 sc = *(const float4*)(mod + 1024 + c);
        const float h0 = (v.x * rstd * gg.x) * (1.f + sc.x) + sh.x;
        const float h1 = (v.y * rstd * gg.y) * (1.f + sc.y) + sh.y;
        const float h2 = (v.z * rstd * gg.z) * (1.f + sc.z) + sh.z;
        const float h3 = (v.w * rstd * gg.w) * (1.f + sc.w) + sh.w;
        uint2 o2; o2.x = pack2(h0, h1); o2.y = pack2(h2, h3);
        *(uint2*)(H + (size_t)row * 1024 + c) = o2;
      }
    }
  }
}

__device__ __forceinline__ void phase_final(const P& p) {
  const int tid = opq_tid(), lane = tid & 63, w = tid >> 6;
  const float* g = p.in[32];
  const int stride = gridDim.x * 8;
  float4 gg[4];
#pragma unroll
  for (int i = 0; i < 4; ++i) gg[i] = *(const float4*)(g + (lane + 64 * i) * 4);
  for (int row0 = blockIdx.x * 8 + w; row0 < NLAT; row0 += 2 * stride) {
    const int row1 = row0 + stride;
    const bool has1 = row1 < NLAT;
    float* s0 = p.out + (size_t)row0 * 1024;
    float* s1 = p.out + (size_t)(has1 ? row1 : row0) * 1024;
    float4 v0[4], v1[4];
#pragma unroll
    for (int i = 0; i < 4; ++i) v0[i] = ((const float4*)s0)[lane + 64 * i];
#pragma unroll
    for (int i = 0; i < 4; ++i) v1[i] = ((const float4*)s1)[lane + 64 * i];
#pragma unroll
    for (int rr = 0; rr < 2; ++rr) {
      if (rr == 1 && !has1) break;
      float* dst = rr ? s1 : s0;
      float ss = 0.f;
#pragma unroll
      for (int i = 0; i < 4; ++i) {
        const float4 v = rr ? v1[i] : v0[i];
        ss += v.x * v.x + v.y * v.y + v.z * v.z + v.w * v.w;
      }
#pragma unroll
      for (int o = 32; o >= 1; o >>= 1) ss += __shfl_xor(ss, o);
      const float rstd = rsqrtf(ss * (1.f / 1024.f) + 1e-6f);
#pragma unroll
      for (int i = 0; i < 4; ++i) {
        const float4 v = rr ? v1[i] : v0[i];
        float4 o4;
        o4.x = v.x * rstd * gg[i].x; o4.y = v.y * rstd * gg[i].y; o4.z = v.z * rstd * gg[i].z; o4.w = v.w * rstd * gg[i].w;
        ((float4*)dst)[lane + 64 * i] = o4;
      }
    }
  }
}

#define WAIT_V(n) asm volatile("s_waitcnt vmcnt(" #n ")" ::: "memory")
#define WAIT_L0() asm volatile("s_waitcnt lgkmcnt(0)" ::: "memory")
constexpr int GSTG = 49152;

__device__ __forceinline__ void glds16(const u16* g, char* l) {
  __builtin_amdgcn_global_load_lds((const unsigned*)g, (__attribute__((address_space(3))) unsigned*)l, 16, 0, 0);
}
__device__ __forceinline__ void gemm_piece(const u16* __restrict__ Ag, const u16* __restrict__ Bg, int k0, char* stg, int tid, int i) {
  if (i < 4) glds16(Ag + (size_t)i * 64 * 1024 + k0, stg + tid * 16 + i * 8192);
  else glds16(Bg + (size_t)(i - 4) * 64 * 1024 + k0, stg + 32768 + tid * 16 + (i - 4) * 8192);
}

#define WAIT_VN(n) asm volatile("s_waitcnt vmcnt(%0)" ::"n"(n) : "memory")
template <bool XPF>
__device__ __forceinline__ void gemm_core(const u16* __restrict__ A, const u16* __restrict__ Bt, int m0, int n0,
                                          char* lds, f32x16 (&acc)[2][2], bool first, bool has_next, int m0n, int n0n,
                                          const float* xsrc, float4 (&xr)[16]) {
  const int tid = opq_tid(), lane = tid & 63, w = tid >> 6, r = lane & 31, hh = lane >> 5;
  const int wm = w >> 1, wn = w & 1;
#pragma unroll
  for (int mi = 0; mi < 2; ++mi)
#pragma unroll
    for (int ni = 0; ni < 2; ++ni) acc[mi][ni] = zero16();
  const int srow = tid >> 3;
  const int gch = (tid & 7) ^ ((srow >> 1) & 7);
  const u16* Ag = A + (size_t)(m0 + srow) * 1024 + gch * 8;
  const u16* Bg = Bt + (size_t)(n0 + srow) * 1024 + gch * 8;
  const int g = (r >> 1) & 7;
  const int aoff = (wm * 64 + r) * 128;
  const int boff = 32768 + (wn * 64 + r) * 128;
  int koff[4];
#pragma unroll
  for (int ks = 0; ks < 4; ++ks) koff[ks] = ((ks * 2 + hh) ^ g) * 16;
  if (first) {
    WAIT_V(0);
    __builtin_amdgcn_s_barrier();
#pragma unroll
    for (int i = 0; i < 6; ++i) gemm_piece(Ag, Bg, 0, lds, tid, i);
#pragma unroll
    for (int i = 0; i < 6; ++i) gemm_piece(Ag, Bg, 64, lds + GSTG, tid, i);
  }
  if (!XPF) {
#pragma unroll 1
    for (int kt = 0; kt < 16; ++kt) {
      if (kt == 15) WAIT_V(0);
      else if (first || kt >= 2) WAIT_V(6);
      else if (kt == 0) WAIT_V(8);
      else WAIT_V(14);
    __builtin_amdgcn_s_barrier();
      const char* st = lds + (kt % 3) * GSTG;
      char* nst = lds + ((kt + 2) % 3) * GSTG;
      const bool more = kt + 2 < 16;
      const int k2 = (kt + 2) * 64;
      bf16x8 a0 = LDS8(st + aoff + koff[0]);
      bf16x8 a1 = LDS8(st + aoff + 32 * 128 + koff[0]);
      bf16x8 b0 = LDS8(st + boff + koff[0]);
      bf16x8 b1 = LDS8(st + boff + 32 * 128 + koff[0]);
#pragma unroll
      for (int ks = 0; ks < 4; ++ks) {
        bf16x8 na0 = a0, na1 = a1, nb0 = b0, nb1 = b1;
        if (ks < 3) {
          na0 = LDS8(st + aoff + koff[ks + 1]);
          na1 = LDS8(st + aoff + 32 * 128 + koff[ks + 1]);
          nb0 = LDS8(st + boff + koff[ks + 1]);
          nb1 = LDS8(st + boff + 32 * 128 + koff[ks + 1]);
        }
        if (more) {
          if (ks == 0) { gemm_piece(Ag, Bg, k2, nst, tid, 0); gemm_piece(Ag, Bg, k2, nst, tid, 1); }
          else if (ks == 1) { gemm_piece(Ag, Bg, k2, nst, tid, 2); gemm_piece(Ag, Bg, k2, nst, tid, 3); }
          else if (ks == 2) gemm_piece(Ag, Bg, k2, nst, tid, 4);
          else gemm_piece(Ag, Bg, k2, nst, tid, 5);
        }
        acc[0][0] = mfma32(a0, b0, acc[0][0]);
        acc[0][1] = mfma32(a0, b1, acc[0][1]);
        acc[1][0] = mfma32(a1, b0, acc[1][0]);
        acc[1][1] = mfma32(a1, b1, acc[1][1]);
        a0 = na0; a1 = na1; b0 = nb0; b1 = nb1;
      }
      }
  } else {
#pragma unroll
    for (int kt = 0; kt < 16; ++kt) {
      if (kt == 0) { if (first) WAIT_V(6); else WAIT_V(16); }
      else if (kt == 1) { if (first) WAIT_V(7); else WAIT_V(23); }
      else if (kt < 15) WAIT_V(8);
      else WAIT_V(2);
    __builtin_amdgcn_s_barrier();
      const char* st = lds + (kt % 3) * GSTG;
      char* nst = lds + ((kt + 2) % 3) * GSTG;
      const bool more = kt + 2 < 16;
      const int k2 = (kt + 2) * 64;
      bf16x8 a0 = LDS8(st + aoff + koff[0]);
      bf16x8 a1 = LDS8(st + aoff + 32 * 128 + koff[0]);
      bf16x8 b0 = LDS8(st + boff + koff[0]);
      bf16x8 b1 = LDS8(st + boff + 32 * 128 + koff[0]);
#pragma unroll
      for (int ks = 0; ks < 4; ++ks) {
        bf16x8 na0 = a0, na1 = a1, nb0 = b0, nb1 = b1;
        if (ks < 3) {
          na0 = LDS8(st + aoff + koff[ks + 1]);
          na1 = LDS8(st + aoff + 32 * 128 + koff[ks + 1]);
          nb0 = LDS8(st + boff + koff[ks + 1]);
          nb1 = LDS8(st + boff + 32 * 128 + koff[ks + 1]);
        }
        if (more) {
          if (ks == 0) { gemm_piece(Ag, Bg, k2, nst, tid, 0); gemm_piece(Ag, Bg, k2, nst, tid, 1); }
          else if (ks == 1) { gemm_piece(Ag, Bg, k2, nst, tid, 2); gemm_piece(Ag, Bg, k2, nst, tid, 3); }
          else if (ks == 2) gemm_piece(Ag, Bg, k2, nst, tid, 4);
          else gemm_piece(Ag, Bg, k2, nst, tid, 5);
        }
        acc[0][0] = mfma32(a0, b0, acc[0][0]);
        acc[0][1] = mfma32(a0, b1, acc[0][1]);
        acc[1][0] = mfma32(a1, b0, acc[1][0]);
        acc[1][1] = mfma32(a1, b1, acc[1][1]);
        a0 = na0; a1 = na1; b0 = nb0; b1 = nb1;
      }
        __builtin_amdgcn_sched_barrier(0);
      {
        const int lr = (tid >> 5) + 16 * (kt & 7);
        const int row = (lr >> 5) * 64 + (kt >> 3) * 32 + (lr & 31);
        xr[kt] = *(const float4*)(xsrc + (size_t)row * 1024);
      }
      __builtin_amdgcn_sched_barrier(0);
    }
  }
  __builtin_amdgcn_s_barrier();
  if (has_next) {
    const u16* Agn = A + (size_t)(m0n + srow) * 1024 + gch * 8;
    const u16* Bgn = Bt + (size_t)(n0n + srow) * 1024 + gch * 8;
#pragma unroll
    for (int i = 0; i < 6; ++i) gemm_piece(Agn, Bgn, 0, lds, tid, i);
#pragma unroll
    for (int i = 0; i < 6; ++i) gemm_piece(Agn, Bgn, 64, lds + GSTG, tid, i);
  }
}

template <bool XPF>
__device__ __forceinline__ void gemm_core16(const u16* __restrict__ A, const u16* __restrict__ Bt, int m0, int n0,
                                          char* lds, f32x4 (&acc)[4][4], bool first, bool has_next, int m0n, int n0n,
                                          const float* xsrc, float4 (&xr)[16]) {
  const int tid = opq_tid(), lane = tid & 63, w = tid >> 6, r16 = lane & 15, q4 = lane >> 4;
  const int wm = w >> 1, wn = w & 1;
#pragma unroll
  for (int mi = 0; mi < 4; ++mi)
#pragma unroll
    for (int ni = 0; ni < 4; ++ni) { acc[mi][ni][0] = 0.f; acc[mi][ni][1] = 0.f; acc[mi][ni][2] = 0.f; acc[mi][ni][3] = 0.f; }
  const int srow = tid >> 3;
  const int gch = (tid & 7) ^ ((srow >> 1) & 7);
  const u16* Ag = A + (size_t)(m0 + srow) * 1024 + gch * 8;
  const u16* Bg = Bt + (size_t)(n0 + srow) * 1024 + gch * 8;
  const int g = (r16 >> 1) & 7;
  const int aoff = (wm * 64 + r16) * 128;
  const int boff = 32768 + (wn * 64 + r16) * 128;
  int koff[2];
#pragma unroll
  for (int ks = 0; ks < 2; ++ks) koff[ks] = ((ks * 4 + q4) ^ g) * 16;
  if (first) {
    WAIT_V(0);
    __builtin_amdgcn_s_barrier();
#pragma unroll
    for (int i = 0; i < 6; ++i) gemm_piece(Ag, Bg, 0, lds, tid, i);
#pragma unroll
    for (int i = 0; i < 6; ++i) gemm_piece(Ag, Bg, 64, lds + GSTG, tid, i);
  }
#define GEMM_KTILE_BODY                                                                               \
      __builtin_amdgcn_s_barrier();                                                                   \
      const char* st = lds + (kt % 3) * GSTG;                                                         \
      char* nst = lds + ((kt + 2) % 3) * GSTG;                                                        \
      const bool more = kt + 2 < 16;                                                                  \
      const int k2 = (kt + 2) * 64;                                                                   \
      _Pragma("unroll") for (int ks = 0; ks < 2; ++ks) {                                              \
        bf16x8 af[4];                                                                                 \
        _Pragma("unroll") for (int i = 0; i < 4; ++i) af[i] = LDS8(st + aoff + i * 2048 + koff[ks]);  \
        bf16x8 bcur = LDS8(st + boff + koff[ks]);                                                     \
        if (more) {                                                                                   \
          _Pragma("unroll") for (int i = 0; i < 3; ++i) gemm_piece(Ag, Bg, k2, nst, tid, ks * 3 + i); \
        }                                                                                             \
        _Pragma("unroll") for (int ni = 0; ni < 4; ++ni) {                                            \
          bf16x8 bnext = bcur;                                                                        \
          if (ni < 3) bnext = LDS8(st + boff + (ni + 1) * 2048 + koff[ks]);                           \
          _Pragma("unroll") for (int mi = 0; mi < 4; ++mi) acc[mi][ni] = mfma16(af[mi], bcur, acc[mi][ni]); \
          bcur = bnext;                                                                               \
        }                                                                                             \
      }
  if (!XPF) {
#pragma unroll
    for (int kt = 0; kt < 16; ++kt) {
      if (kt == 15) WAIT_V(0);
      else if (first || kt >= 2) WAIT_V(6);
      else if (kt == 0) WAIT_V(8);
      else WAIT_V(14);
      GEMM_KTILE_BODY
    }
  } else {
#pragma unroll
    for (int kt = 0; kt < 16; ++kt) {
      if (kt == 0) { if (first) WAIT_V(6); else WAIT_V(16); }
      else if (kt == 1) { if (first) WAIT_V(7); else WAIT_V(23); }
      else if (kt < 15) WAIT_V(8);
      else WAIT_V(2);
      GEMM_KTILE_BODY
      __builtin_amdgcn_sched_barrier(0);
      {
        const int lr = (tid >> 5) + 16 * (kt & 7);
        const int row = (lr >> 5) * 64 + (kt >> 3) * 32 + (lr & 31);
        xr[kt] = *(const float4*)(xsrc + (size_t)row * 1024);
      }
      __builtin_amdgcn_sched_barrier(0);
    }
  }
#undef GEMM_KTILE_BODY
  __builtin_amdgcn_s_barrier();
  if (has_next) {
    const u16* Agn = A + (size_t)(m0n + srow) * 1024 + gch * 8;
    const u16* Bgn = Bt + (size_t)(n0n + srow) * 1024 + gch * 8;
#pragma unroll
    for (int i = 0; i < 6; ++i) gemm_piece(Agn, Bgn, 0, lds, tid, i);
#pragma unroll
    for (int i = 0; i < 6; ++i) gemm_piece(Agn, Bgn, 64, lds + GSTG, tid, i);
  }
}

__device__ __forceinline__ void phase_gemm_in(const P& p, int l, char* lds) {
  const int tid = opq_tid(), lane = tid & 63, w = tid >> 6, r16 = lane & 15, q4 = lane >> 4;
  const int wm = w >> 1, wn = w & 1;
  const bool odd = (l & 1) != 0;
  const int NT = odd ? 22 : 21;
  const u16* A = (const u16*)(p.ws + OFF_HY);
  const u16* Bt = (const u16*)(p.ws + OFF_WIN) + (size_t)l * 2816 * 1024;
  u16* Z = (u16*)(p.ws + OFF_Z);
  const float rinv = powf(10000.f, -(float)r16 / 16.f);
  const int xcd = blockIdx.x & 7, slot = blockIdx.x >> 3, nslot = gridDim.x >> 3;
  const int nmt = (130 - xcd + 7) >> 3;
  bool first = true;
  for (int q = slot; q < nmt * NT; q += nslot) {
    const int mt = xcd + 8 * (q / NT), nt = q % NT;
    const int m0 = mt * 256, n0 = nt * 128;
    const int q2 = q + nslot;
    const bool has_next = q2 < nmt * NT;
    f32x4 acc[4][4];
    float4 xdummy[16];
    gemm_core16<false>(A, Bt, m0, n0, lds, acc, first, has_next, (xcd + 8 * (q2 / NT)) * 256, (q2 % NT) * 128, nullptr, xdummy);
    first = false;
    const int cb = n0 + wn * 64;
    if (odd && mt < 128 && (cb < 640 || (cb >= 1280 && cb < 1792))) {
#pragma unroll
      for (int mi = 0; mi < 4; ++mi)
#pragma unroll
        for (int j = 0; j < 4; ++j) {
          const int row = m0 + wm * 64 + mi * 16 + q4 * 4 + j;
          const int tt = row & (L - 1);
#pragma unroll
          for (int ni = 0; ni < 2; ++ni) {
            const float ang = (float)(ni == 0 ? (tt >> 6) : (tt & 63)) * rinv;
            const float sn = __sinf(ang), cn = __cosf(ang);
            const float x1 = acc[mi][ni][j], x2 = acc[mi][ni + 2][j];
            acc[mi][ni][j] = x1 * cn - x2 * sn;
            acc[mi][ni + 2][j] = x1 * sn + x2 * cn;
          }
        }
    }
    {
      u16* C_s = (u16*)(lds + 2 * GSTG);
#pragma unroll
      for (int mi = 0; mi < 4; ++mi)
#pragma unroll
        for (int ni = 0; ni < 4; ++ni)
#pragma unroll
          for (int j = 0; j < 4; ++j)
            C_s[(wm * 64 + mi * 16 + q4 * 4 + j) * 128 + wn * 64 + ni * 16 + r16] = f2bf(acc[mi][ni][j]);
      __syncthreads();
#pragma unroll
      for (int it = 0; it < 8; ++it) {
        const int cc = tid + 512 * it, row = cc >> 4, c16 = cc & 15;
        *(uint4*)(Z + (size_t)(m0 + row) * ZW + n0 + c16 * 8) = *(const uint4*)(C_s + row * 128 + c16 * 8);
      }
    }
  }
}

__device__ __forceinline__ void phase_gemm_out(const P& p, int l, char* lds) {
  const int tid = opq_tid(), lane = tid & 63, w = tid >> 6, r = lane & 31, hh = lane >> 5;
  const int wm = w >> 1, wn = w & 1;
  const u16* A = (const u16*)(p.ws + OFF_HY);
  const u16* Bt = (const u16*)(p.ws + OFF_WOUT) + (size_t)l * 1024 * 1024;
  const int MT = (l == 3) ? 128 : 130;
  const int xcd = blockIdx.x & 7, slot = blockIdx.x >> 3, nslot = gridDim.x >> 3;
  const int nmt = (MT - xcd + 7) >> 3;
  bool first = true;
  for (int q = slot; q < nmt * 8; q += nslot) {
    const int mt = xcd + 8 * (q >> 3), nt = q & 7;
    const int m0 = mt * 256, n0 = nt * 128;
    const int q2 = q + nslot;
    const bool has_next = q2 < nmt * 8;
    const int m = mt < 64 ? 0 : (mt < 128 ? 1 : 2);
    const float* gate = (const float*)(p.ws + OFF_MOD) + (l * 3 + m) * 3072 + 2048;
    const float* src; float* dst;
    if (mt < 128) { src = (l == 0 ? p.in[0] : p.out) + (size_t)m0 * 1024; dst = p.out + (size_t)m0 * 1024; }
    else { src = (l == 0 ? p.in[2] : (const float*)(p.ws + OFF_CTXX)) + (size_t)(m0 - NLAT) * 1024; dst = (float*)(p.ws + OFF_CTXX) + (size_t)(m0 - NLAT) * 1024; }
    f32x16 acc[2][2];
    float4 xr[16];
    gemm_core<true>(A, Bt, m0, n0, lds, acc, first, has_next, (xcd + 8 * (q2 >> 3)) * 256, (q2 & 7) * 128, src + n0 + (tid & 31) * 4, xr);
    first = false;
    {
      float* C_f = (float*)(lds + 2 * GSTG);
      const int c4 = (tid & 31) * 4;
      const float4 gv = *(const float4*)(gate + n0 + c4);
#pragma unroll
      for (int mi = 0; mi < 2; ++mi) {
        if (mi) __syncthreads();
#pragma unroll
        for (int ni = 0; ni < 2; ++ni)
#pragma unroll
          for (int i = 0; i < 16; ++i)
            C_f[(wm * 32 + 8 * (i >> 2) + 4 * hh + (i & 3)) * 128 + wn * 64 + ni * 32 + r] = acc[mi][ni][i];
        __syncthreads();
#pragma unroll
        for (int it = 0; it < 8; ++it) {
          const int lr = (tid >> 5) + 16 * it;
          const int row = (lr >> 5) * 64 + mi * 32 + (lr & 31);
          const float4 a4 = *(const float4*)(C_f + lr * 128 + c4);
          const size_t o = (size_t)row * 1024 + n0 + c4;
          const float4 x4 = xr[mi * 8 + it];
          float4 y4;
          y4.x = x4.x + gv.x * a4.x; y4.y = x4.y + gv.y * a4.y; y4.z = x4.z + gv.z * a4.z; y4.w = x4.w + gv.w * a4.w;
          *(float4*)(dst + o) = y4;
        }
      }
    }
  }
}

__device__ __forceinline__ void gla_dir_pass(const P& p, const MixCfg& c, int b, int h, int dir, int pidx, char* lds, const bool OUT, bool second,
                                             const int cend, const int cout_from, const bool write_state) {
  const int tid = opq_tid(), lane = tid & 63, w = tid >> 6, r = lane & 31, hh = lane >> 5;
  float* lr_s = (float*)(lds);
  float* b_s = (float*)(lds + 4096);
  float* tot_s = (float*)(lds + 20480);
  float* blast_s = (float*)(lds + 22528);
  u16* qin_s = (u16*)(lds + 22784);
  u16* kin_s = (u16*)(lds + 32000);
  u16* kst_s = (u16*)(lds + 41216);
  u16* V_s = (u16*)(lds + 53504);
  u16* St_s = (u16*)(lds + 73984);
  u16* att_s = (u16*)(lds + 92416);
  float* o_s = (float*)(lds + 101632);
  const int trk = tr_lane_off(lane, 96), trv = tr_lane_off(lane, 160);
  const u16* Z = (const u16*)(p.ws + OFF_Z);
  u16* Y = (u16*)(p.ws + OFF_HY);
  float* GS = (float*)(p.ws + OFF_GS);
  float* GD = (float*)(p.ws + OFF_GD);

  int seq, tbase;
  if (pidx == 0) { seq = 2 + b; tbase = 0; }
  else { const int seg = dir ? 64 - pidx : pidx - 1; seq = b; tbase = seg * 256; }
  const int d = tid & 63, part = tid >> 6;
  float upw[16], ubias = 0.f, lg = 0.f;
  if (!c.ret) {
#pragma unroll
    for (int rr = 0; rr < 16; ++rr) upw[rr] = (dir ? c.up1 : c.up0)[rr * 256 + h * 64 + d];
    ubias = (dir ? c.ub1 : c.ub0)[h * 64 + d];
  } else {
#pragma unroll
    for (int rr = 0; rr < 16; ++rr) upw[rr] = 0.f;
    lg = logsigf_((dir ? c.dec1 : c.dec0)[h]);
  }
  const size_t sidx = ((size_t)(dir * 2 + b) * 4 + h) * 65 + pidx;
  float* GSp = GS + sidx * 8192;
  const int mt = w >> 2, nt = w & 3;
  f32x16 accS;
  if (OUT && pidx != 0) {
#pragma unroll
    for (int i = 0; i < 16; ++i) accS[i] = GSp[(mt * 32 + 8 * (i >> 2) + 4 * hh + (i & 3)) * 128 + nt * 32 + r];
  } else {
    accS = zero16();
  }
  float sumbl = 0.f;
  uint4 lrv = make_uint4(0, 0, 0, 0), kvr, qvr = make_uint4(0, 0, 0, 0), v0r, v1r;
  uint4 o0r = make_uint4(0, 0, 0, 0), o1r = o0r, g0r = o0r, g1r = o0r;
  auto growf = [&](int cc, int row) {
    const int tbb = tbase + 64 * (dir ? 3 - cc : cc);
    return rowof(seq, dir ? tbb + 63 - row : tbb + row);
  };
  auto issue_lr = [&](int cc) {
    if (!c.ret && tid < 128)
      lrv = *(const uint4*)(Z + (size_t)growf(cc, tid >> 1) * ZW + c.lrcol + dir * 16 + (tid & 1) * 8);
  };
  auto issue_kqv = [&](int cc) {
    const u16* zr = Z + (size_t)growf(cc, tid >> 3) * ZW;
    kvr = *(const uint4*)(zr + c.kcol + h * 64 + (tid & 7) * 8);
    if (OUT) qvr = *(const uint4*)(zr + c.qcol + h * 64 + (tid & 7) * 8);
    v0r = *(const uint4*)(zr + c.vcol + h * 128 + (tid & 7) * 16);
    v1r = *(const uint4*)(zr + c.vcol + h * 128 + (tid & 7) * 16 + 8);
  };
  auto issue_epi = [&](int cc) {
    if (OUT && second) {
      const int grow = growf(cc, tid >> 3);
      const u16* yq = Y + (size_t)grow * 1024 + c.ycol + h * 128 + (tid & 7) * 16;
      o0r = *(const uint4*)(yq);
      o1r = *(const uint4*)(yq + 8);
      const u16* gq = Z + (size_t)grow * ZW + c.gcol + h * 128 + (tid & 7) * 16;
      g0r = *(const uint4*)(gq);
      g1r = *(const uint4*)(gq + 8);
    }
  };
  float ngr[16];
#pragma unroll
  for (int j = 0; j < 16; ++j) ngr[j] = (OUT && second) ? c.ng[(tid & 7) * 16 + j] : 0.f;
  issue_lr(0);
  issue_kqv(0);
  issue_epi(cout_from);
  for (int cidx = 0; cidx < cend; ++cidx) {
    const bool outc = OUT && cidx >= cout_from;
    const int tb = tbase + 64 * (dir ? 3 - cidx : cidx);
    if (!c.ret) {
      if (tid < 128) {
        const int row = tid >> 1, half = tid & 1;
        float f[8];
        unpack8(lrv, f);
#pragma unroll
        for (int j = 0; j < 8; ++j) lr_s[row * 16 + half * 8 + j] = f[j];
      }
      if (cidx + 1 < cend) issue_lr(cidx + 1);
      __syncthreads();
    }
    if (!c.ret) {
      float cumv[8];
      {
        float cum = 0.f;
#pragma unroll
        for (int jj = 0; jj < 8; ++jj) {
          const int j = part * 8 + jj;
          float x = ubias;
#pragma unroll
          for (int q = 0; q < 4; ++q) {
            const float4 l4 = *(const float4*)(lr_s + j * 16 + 4 * q);
            x += l4.x * upw[4 * q] + l4.y * upw[4 * q + 1] + l4.z * upw[4 * q + 2] + l4.w * upw[4 * q + 3];
          }
          cum += logsigf_(x) * (1.f / 16.f);
          cumv[jj] = cum;
        }
        tot_s[part * 64 + d] = cum;
      }
      __syncthreads();
      {
        float off = 0.f;
        for (int pp = 0; pp < part; ++pp) off += tot_s[pp * 64 + d];
#pragma unroll
        for (int jj = 0; jj < 8; ++jj) b_s[(part * 8 + jj) * 64 + d] = cumv[jj] + off;
        if (part == 7) blast_s[d] = cumv[7] + off;
      }
      __syncthreads();
      if (tid < 64) sumbl += blast_s[tid];
    } else {
      sumbl += 64.f * lg;
    }
    {
      const int row = tid >> 3, c8 = (tid & 7) * 8;
      const uint4 kv = kvr;
      float kf[8], bv[8], tmp[8];
      unpack8(kv, kf);
      if (!c.ret) {
        float bl8[8];
        {
          const float4 b0 = *(const float4*)(b_s + row * 64 + c8), b1 = *(const float4*)(b_s + row * 64 + c8 + 4);
          const float4 l0 = *(const float4*)(blast_s + c8), l1 = *(const float4*)(blast_s + c8 + 4);
          bv[0] = b0.x; bv[1] = b0.y; bv[2] = b0.z; bv[3] = b0.w; bv[4] = b1.x; bv[5] = b1.y; bv[6] = b1.z; bv[7] = b1.w;
          bl8[0] = l0.x; bl8[1] = l0.y; bl8[2] = l0.z; bl8[3] = l0.w; bl8[4] = l1.x; bl8[5] = l1.y; bl8[6] = l1.z; bl8[7] = l1.w;
        }
#pragma unroll
        for (int j = 0; j < 8; ++j) tmp[j] = kf[j] * fexp(-bv[j]);
        *(uint4*)(kin_s + row * 72 + c8) = pack8(tmp);
#pragma unroll
        for (int j = 0; j < 8; ++j) tmp[j] = kf[j] * fexp(bl8[j] - bv[j]);
        *(uint4*)(kst_s + row * 96 + c8) = pack8(tmp);
      } else {
        const float bb = (float)(row + 1) * lg;
        const float e1 = fexp(-bb), e2 = fexp(64.f * lg - bb);
#pragma unroll
        for (int j = 0; j < 8; ++j) { bv[j] = bb; tmp[j] = kf[j] * e1; }
        *(uint4*)(kin_s + row * 72 + c8) = pack8(tmp);
#pragma unroll
        for (int j = 0; j < 8; ++j) tmp[j] = kf[j] * e2;
        *(uint4*)(kst_s + row * 96 + c8) = pack8(tmp);
      }
      if (outc) {
        const uint4 qv = qvr;
        float qf[8];
        unpack8(qv, qf);
#pragma unroll
        for (int j = 0; j < 8; ++j) tmp[j] = qf[j] * fexp(bv[j]);
        *(uint4*)(qin_s + row * 72 + c8) = pack8(tmp);
      }
      const int v16 = (tid & 7) * 16;
      *(uint4*)(V_s + row * 160 + v16) = v0r;
      *(uint4*)(V_s + row * 160 + v16 + 8) = v1r;
      if (outc) {
#pragma unroll
        for (int g = 0; g < 4; ++g) {
          uint2 s2;
          s2.x = pack2(accS[4 * g], accS[4 * g + 1]);
          s2.y = pack2(accS[4 * g + 2], accS[4 * g + 3]);
          *(uint2*)(St_s + (nt * 32 + r) * 72 + mt * 32 + 8 * g + 4 * hh) = s2;
        }
      }
      if (cidx + 1 < cend) issue_kqv(cidx + 1);
    }
    __syncthreads();
    if (outc) {
      if (w < 4) {
        const int ms = w >> 1, ntq = w & 1;
        f32x16 a = zero16();
#pragma unroll
        for (int ks = 0; ks < 4; ++ks)
          a = mfma32(LDS8(kin_s + (ms * 32 + r) * 72 + ks * 16 + hh * 8), LDS8(qin_s + (ntq * 32 + r) * 72 + ks * 16 + hh * 8), a);
        const int t = ntq * 32 + r;
#pragma unroll
        for (int g = 0; g < 4; ++g) {
          const int s0 = ms * 32 + 8 * g + 4 * hh;
          float f[4];
#pragma unroll
          for (int j = 0; j < 4; ++j) f[j] = (s0 + j <= t) ? a[4 * g + j] : 0.f;
          uint2 s2;
          s2.x = pack2(f[0], f[1]); s2.y = pack2(f[2], f[3]);
          *(uint2*)(att_s + t * 72 + s0) = s2;
        }
      }
      __syncthreads();
    }
    f32x16 accO = zero16();
    const int mo = w >> 2;
    if (outc) {
#pragma unroll
      for (int ks = 0; ks < 4; ++ks)
        accO = mfma32(tr_frag(V_s, 160, ks, nt, trv), LDS8(att_s + (mo * 32 + r) * 72 + ks * 16 + hh * 8), accO);
#pragma unroll
      for (int ks = 0; ks < 4; ++ks)
        accO = mfma32(LDS8(St_s + (nt * 32 + r) * 72 + ks * 16 + hh * 8), LDS8(qin_s + (mo * 32 + r) * 72 + ks * 16 + hh * 8), accO);
    }
    if (!c.ret) {
#pragma unroll
      for (int g = 0; g < 4; ++g) {
        const float4 l4 = *(const float4*)(blast_s + mt * 32 + 8 * g + 4 * hh);
        accS[4 * g] *= fexp(l4.x); accS[4 * g + 1] *= fexp(l4.y); accS[4 * g + 2] *= fexp(l4.z); accS[4 * g + 3] *= fexp(l4.w);
      }
    } else {
      const float dk = fexp(64.f * lg);
#pragma unroll
      for (int i = 0; i < 16; ++i) accS[i] *= dk;
    }
#pragma unroll
    for (int ks = 0; ks < 4; ++ks)
      accS = mfma32(tr_frag(kst_s, 96, ks, mt, trk), tr_frag(V_s, 160, ks, nt, trv), accS);
    if (outc) {
#pragma unroll
      for (int g = 0; g < 4; ++g)
        *(float4*)(o_s + (mo * 32 + r) * 132 + nt * 32 + 8 * g + 4 * hh) = make_float4(accO[4 * g], accO[4 * g + 1], accO[4 * g + 2], accO[4 * g + 3]);
      __syncthreads();
      const int row = tid >> 3, v16 = (tid & 7) * 16;
      const int grow = rowof(seq, dir ? tb + 63 - row : tb + row);
      float vals[16];
#pragma unroll
      for (int q = 0; q < 4; ++q) {
        const float4 t4 = *(const float4*)(o_s + row * 132 + v16 + 4 * q);
        vals[4 * q] = t4.x; vals[4 * q + 1] = t4.y; vals[4 * q + 2] = t4.z; vals[4 * q + 3] = t4.w;
      }
      u16* yp = Y + (size_t)grow * 1024 + c.ycol + h * 128 + v16;
      if (!second) {
        *(uint4*)(yp) = pack8(vals);
        *(uint4*)(yp + 8) = pack8(vals + 8);
      } else {
        const uint4 o0 = o0r, o1 = o1r;
        float ob[16];
        unpack8(o0, ob);
        unpack8(o1, ob + 8);
        float ss = 0.f;
#pragma unroll
        for (int j = 0; j < 16; ++j) { vals[j] += ob[j]; ss += vals[j] * vals[j]; }
        ss += __shfl_xor(ss, 1);
        ss += __shfl_xor(ss, 2);
        ss += __shfl_xor(ss, 4);
        const float rstd = rsqrtf(ss * (1.f / 128.f) + 1e-6f);
        const uint4 g0 = g0r, g1 = g1r;
        float gf[16];
        unpack8(g0, gf);
        unpack8(g1, gf + 8);
#pragma unroll
        for (int j = 0; j < 16; ++j) vals[j] = (vals[j] * rstd * ngr[j]) * siluf_(gf[j]);
        *(uint4*)(yp) = pack8(vals);
        *(uint4*)(yp + 8) = pack8(vals + 8);
        if (cidx + 1 < cend) issue_epi(cidx + 1);
      }
    } else if (c.ret) {
      __syncthreads();
    }
  }
  if (write_state) {
#pragma unroll
    for (int i = 0; i < 16; ++i) GSp[(mt * 32 + 8 * (i >> 2) + 4 * hh + (i & 3)) * 128 + nt * 32 + r] = accS[i];
    if (tid < 64) GD[sidx * 64 + tid] = fexp(sumbl);
  }
  __syncthreads();
}

__device__ __forceinline__ void gla_passA(const P& p, const MixCfg& c, int b, int h, int seq, int tbase, int pf, int pb, char* lds) {
  const int tid = opq_tid(), lane = tid & 63, w = tid >> 6, r = lane & 31, hh = lane >> 5;
  float* lr_s = (float*)(lds);
  float* b_s = (float*)(lds + 8192);
  float* tot_s = (float*)(lds + 40960);
  float* blast_s = (float*)(lds + 45056);
  float* dacc_s = (float*)(lds + 45568);
  u16* kst_s = (u16*)(lds + 45824);
  u16* V_s = (u16*)(lds + 70400);
  const u16* Z = (const u16*)(p.ws + OFF_Z);
  float* GS = (float*)(p.ws + OFF_GS);
  float* GD = (float*)(p.ws + OFF_GD);
  const int trk = tr_lane_off(lane, 96), trv = tr_lane_off(lane, 160);
  const int dir2 = tid >> 8, d = tid & 63, part = (tid >> 6) & 3;
  float upw[16], ubias = 0.f;
  const float lgf = c.ret ? logsigf_(c.dec0[h]) : 0.f, lgb = c.ret ? logsigf_(c.dec1[h]) : 0.f;
  if (!c.ret) {
#pragma unroll
    for (int rr = 0; rr < 16; ++rr) upw[rr] = (dir2 ? c.up1 : c.up0)[rr * 256 + h * 64 + d];
    ubias = (dir2 ? c.ub1 : c.ub0)[h * 64 + d];
  } else {
#pragma unroll
    for (int rr = 0; rr < 16; ++rr) upw[rr] = 0.f;
  }
  const int mt = w >> 2, nt = w & 3;
  f32x16 accF = zero16(), accB = zero16();
  float sumf = 0.f, sumb = 0.f;
  uint4 lrv = make_uint4(0, 0, 0, 0), kvr, v0r, v1r;
  auto issue = [&](int cc) {
    const int tb = tbase + 64 * cc;
    if (!c.ret && tid < 256) lrv = *(const uint4*)(Z + (size_t)rowof(seq, tb + (tid >> 2)) * ZW + c.lrcol + (tid & 3) * 8);
    const u16* zr = Z + (size_t)rowof(seq, tb + (tid >> 3)) * ZW;
    kvr = *(const uint4*)(zr + c.kcol + h * 64 + (tid & 7) * 8);
    v0r = *(const uint4*)(zr + c.vcol + h * 128 + (tid & 7) * 16);
    v1r = *(const uint4*)(zr + c.vcol + h * 128 + (tid & 7) * 16 + 8);
  };
  issue(0);
  if (tid < 64) dacc_s[tid] = 0.f;
#pragma unroll
  for (int cidx = 0; cidx < 4; ++cidx) {
    if (!c.ret) {
      if (tid < 256) {
        float f[8];
        unpack8(lrv, f);
#pragma unroll
        for (int j = 0; j < 8; ++j) lr_s[(tid >> 2) * 32 + (tid & 3) * 8 + j] = f[j];
      }
      __syncthreads();
      float cumv[16];
      {
        float cum = 0.f;
#pragma unroll
        for (int jj = 0; jj < 16; ++jj) {
          const int j = part * 16 + jj;
          float x = ubias;
#pragma unroll
          for (int q = 0; q < 4; ++q) {
            const float4 l4 = *(const float4*)(lr_s + j * 32 + dir2 * 16 + 4 * q);
            x += l4.x * upw[4 * q] + l4.y * upw[4 * q + 1] + l4.z * upw[4 * q + 2] + l4.w * upw[4 * q + 3];
          }
          cum += logsigf_(x) * (1.f / 16.f);
          cumv[jj] = cum;
        }
        tot_s[(dir2 * 4 + part) * 64 + d] = cum;
      }
      __syncthreads();
      {
        float off = 0.f;
        for (int pp = 0; pp < part; ++pp) off += tot_s[(dir2 * 4 + pp) * 64 + d];
#pragma unroll
        for (int jj = 0; jj < 16; ++jj) b_s[(dir2 * 64 + part * 16 + jj) * 64 + d] = cumv[jj] + off;
        if (part == 3) blast_s[dir2 * 64 + d] = cumv[15] + off;
      }
      __syncthreads();
    }
    {
      const int row = tid >> 3, c8 = (tid & 7) * 8;
      float kf[8], tf[8], tb8[8];
      unpack8(kvr, kf);
      if (!c.ret) {
        float bf8[8], bl8[8], ex8[8], da8[8];
        {
          const float4 a0 = *(const float4*)(b_s + row * 64 + c8), a1 = *(const float4*)(b_s + row * 64 + c8 + 4);
          const float4 l0 = *(const float4*)(blast_s + c8), l1 = *(const float4*)(blast_s + c8 + 4);
          const float4 d0 = *(const float4*)(dacc_s + c8), d1 = *(const float4*)(dacc_s + c8 + 4);
          float4 e0 = make_float4(0.f, 0.f, 0.f, 0.f), e1 = e0;
          if (row > 0) { e0 = *(const float4*)(b_s + (64 + row - 1) * 64 + c8); e1 = *(const float4*)(b_s + (64 + row - 1) * 64 + c8 + 4); }
          bf8[0] = a0.x; bf8[1] = a0.y; bf8[2] = a0.z; bf8[3] = a0.w; bf8[4] = a1.x; bf8[5] = a1.y; bf8[6] = a1.z; bf8[7] = a1.w;
          bl8[0] = l0.x; bl8[1] = l0.y; bl8[2] = l0.z; bl8[3] = l0.w; bl8[4] = l1.x; bl8[5] = l1.y; bl8[6] = l1.z; bl8[7] = l1.w;
          da8[0] = d0.x; da8[1] = d0.y; da8[2] = d0.z; da8[3] = d0.w; da8[4] = d1.x; da8[5] = d1.y; da8[6] = d1.z; da8[7] = d1.w;
          ex8[0] = e0.x; ex8[1] = e0.y; ex8[2] = e0.z; ex8[3] = e0.w; ex8[4] = e1.x; ex8[5] = e1.y; ex8[6] = e1.z; ex8[7] = e1.w;
        }
#pragma unroll
        for (int j = 0; j < 8; ++j) {
          tf[j] = kf[j] * fexp(bl8[j] - bf8[j]);
          tb8[j] = kf[j] * fexp(ex8[j] + da8[j]);
        }
      } else {
        const float ef = fexp((float)(63 - row) * lgf), eb = fexp((float)(row + 64 * cidx) * lgb);
#pragma unroll
        for (int j = 0; j < 8; ++j) { tf[j] = kf[j] * ef; tb8[j] = kf[j] * eb; }
      }
      *(uint4*)(kst_s + row * 96 + c8) = pack8(tf);
      *(uint4*)(kst_s + (64 + row) * 96 + c8) = pack8(tb8);
      const int v16 = (tid & 7) * 16;
      *(uint4*)(V_s + row * 160 + v16) = v0r;
      *(uint4*)(V_s + row * 160 + v16 + 8) = v1r;
      if (cidx + 1 < 4) issue(cidx + 1);
    }
    __syncthreads();
    if (!c.ret) {
#pragma unroll
      for (int g = 0; g < 4; ++g) {
        const float4 l4 = *(const float4*)(blast_s + mt * 32 + 8 * g + 4 * hh);
        accF[4 * g] *= fexp(l4.x); accF[4 * g + 1] *= fexp(l4.y); accF[4 * g + 2] *= fexp(l4.z); accF[4 * g + 3] *= fexp(l4.w);
      }
    } else {
      const float dk = fexp(64.f * lgf);
#pragma unroll
      for (int i = 0; i < 16; ++i) accF[i] *= dk;
    }
#pragma unroll
    for (int ks = 0; ks < 4; ++ks) {
      const bf16x8 vb = tr_frag(V_s, 160, ks, nt, trv);
      accF = mfma32(tr_frag(kst_s, 96, ks, mt, trk), vb, accF);
      accB = mfma32(tr_frag(kst_s + 64 * 96, 96, ks, mt, trk), vb, accB);
    }
    if (!c.ret) {
      if (tid < 64) { sumf += blast_s[tid]; sumb += blast_s[64 + tid]; }
    } else {
      sumf += 64.f * lgf; sumb += 64.f * lgb;
    }
    __syncthreads();
    if (!c.ret && tid < 64) dacc_s[tid] = sumb;
  }
  {
    float* GF = GS + (((size_t)(0 * 2 + b) * 4 + h) * 65 + pf) * 8192;
    float* GB = GS + (((size_t)(1 * 2 + b) * 4 + h) * 65 + pb) * 8192;
#pragma unroll
    for (int i = 0; i < 16; ++i) {
      const int o = (mt * 32 + 8 * (i >> 2) + 4 * hh + (i & 3)) * 128 + nt * 32 + r;
      GF[o] = accF[i];
      GB[o] = accB[i];
    }
    if (tid < 64) {
      GD[(((size_t)(0 * 2 + b) * 4 + h) * 65 + pf) * 64 + tid] = fexp(sumf);
      GD[(((size_t)(1 * 2 + b) * 4 + h) * 65 + pb) * 64 + tid] = fexp(sumb);
    }
  }
  __syncthreads();
}

__device__ __forceinline__ void lru_coeff_item(const P& p, int jl, int b, int sidx, int nblk, char* lds) {
  const int tid0 = opq_tid();
  u16* xr_s = (u16*)(lds);
  u16* xcb = (u16*)(lds + 17408);
  float* xcf = (float*)(lds + 34816);
  u16* la_s = (u16*)(lds + 67584);
  u16* u_s = (u16*)(lds + 102400);
  const u16* Z = (const u16*)(p.ws + OFF_Z);
  u16* LA = (u16*)(p.ws + OFF_LA);
  u16* LU = (u16*)(p.ws + OFF_LU);
  float* LSA = (float*)(p.ws + OFF_LSA);
  float* LSU = (float*)(p.ws + OFF_LSU);
  int seq, tbase, Ls;
  if (sidx < 2) { seq = 2 + b; tbase = sidx * 128; Ls = LC; }
  else { seq = b; tbase = (sidx - 2) * 128; Ls = L; }
  const int dir0 = tid0 >> 8;
  const u16* WL = (const u16*)(p.ws + OFF_WLRU);
  const int gchl = jl * 512 + nblk * 128 + ((tid0 >> 6) & 3) * 32 + (tid0 & 31);
  const float ba = (dir0 ? p.in[21] : p.in[16])[gchl];
  const float bx = (dir0 ? p.in[23] : p.in[18])[gchl];
  const float c8l = 8.f * logsigf_((dir0 ? p.in[24] : p.in[19])[gchl]);
  float LAacc = 0.f, Uacc = 0.f;
  float w0[4], w1[4], cb0, cb1;
  {
    const int ch2 = (tid0 & 63) * 2;
    const float* cw = p.in[13] + jl * 4 * 512 + nblk * 128 + ch2;
    const float* cbp = p.in[14] + jl * 512 + nblk * 128 + ch2;
#pragma unroll
    for (int j = 0; j < 4; ++j) { w0[j] = cw[j * 512]; w1[j] = cw[j * 512 + 1]; }
    cb0 = cbp[0]; cb1 = cbp[1];
  }
  uint4 xv[3];
  auto issue_xr = [&](int stt) {
#pragma unroll
    for (int q = 0; q < 3; ++q) {
      const int cc = tid0 + 512 * q;
      const int jj = cc >> 4, c8 = (cc & 15) * 8;
      const int t = tbase + 64 * stt - 2 + jj;
      xv[q] = make_uint4(0, 0, 0, 0);
      if (cc < 67 * 16 && t >= 0 && t < Ls) xv[q] = *(const uint4*)(Z + (size_t)rowof(seq, t) * ZW + 1568 + nblk * 128 + c8);
    }
  };
  issue_xr(0);
#pragma unroll 1
  for (int st = 0; st < 2; ++st) {
    const int tid = opq_tid(), lane = tid & 63, w = tid >> 6, r = lane & 31, hh = lane >> 5;
    const int dir = w >> 2, nq = w & 3;
    const int t0 = tbase + 64 * st;
#pragma unroll
    for (int q = 0; q < 3; ++q) {
      const int cc = tid + 512 * q;
      if (cc < 67 * 16) *(uint4*)(xr_s + (cc >> 4) * 128 + (cc & 15) * 8) = xv[q];
    }
    if (st == 0) issue_xr(1);
    bf16x8 bq0[8];
    {
      const u16* wb = WL + (size_t)((jl * 4 + dir * 2 + 0) * 4 + nblk) * 16384 + (nq * 8 * 64 + lane) * 8;
#pragma unroll
      for (int ks = 0; ks < 8; ++ks) bq0[ks] = *(const bf16x8*)(wb + ks * 512);
    }
    __syncthreads();
    {
      const int ch2 = (tid & 63) * 2, r0 = (tid >> 6) * 8;
      float x0[11], x1[11];
#pragma unroll
      for (int j = 0; j < 11; ++j) {
        const unsigned u = *(const unsigned*)(xr_s + (r0 + j) * 128 + ch2);
        x0[j] = lo2f(u); x1[j] = hi2f(u);
      }
#pragma unroll
      for (int rr = 0; rr < 8; ++rr) {
        float a0 = cb0, a1 = cb1;
#pragma unroll
        for (int j = 0; j < 4; ++j) { a0 += w0[j] * x0[rr + j]; a1 += w1[j] * x1[rr + j]; }
        *(float2*)(xcf + (r0 + rr) * 128 + ch2) = make_float2(a0, a1);
        *(unsigned*)(xcb + (r0 + rr) * 136 + ch2) = pack2(a0, a1);
      }
    }
    __syncthreads();
    float lav[2][16];
#pragma unroll
    for (int mat = 0; mat < 2; ++mat) {
      const u16* wb = WL + (size_t)((jl * 4 + dir * 2 + mat) * 4 + nblk) * 16384 + (nq * 8 * 64 + lane) * 8;
      f32x16 acc0 = zero16(), acc1 = zero16();
#pragma unroll
      for (int ks = 0; ks < 8; ++ks) {
        const bf16x8 bq = (mat == 0) ? bq0[ks] : *(const bf16x8*)(wb + ks * 512);
        acc0 = mfma32(LDS8(xcb + r * 136 + ks * 16 + hh * 8), bq, acc0);
        acc1 = mfma32(LDS8(xcb + (32 + r) * 136 + ks * 16 + hh * 8), bq, acc1);
      }
      const int ch = nq * 32 + r;
      if (mat == 0) {
#pragma unroll
        for (int i = 0; i < 16; ++i) { lav[0][i] = c8l * sigmoidf_(acc0[i] + ba); lav[1][i] = c8l * sigmoidf_(acc1[i] + ba); }
      } else {
#pragma unroll
        for (int mi = 0; mi < 2; ++mi)
#pragma unroll
          for (int g4 = 0; g4 < 4; ++g4) {
            float lq[4], uq[4];
#pragma unroll
            for (int j = 0; j < 4; ++j) {
              const int i = 4 * g4 + j;
              const int row = mi * 32 + 8 * g4 + 4 * hh + j;
              const float ig = sigmoidf_((mi ? acc1[i] : acc0[i]) + bx);
              const float la = lav[mi][i];
              lq[j] = la;
              uq[j] = __builtin_amdgcn_sqrtf(fmaxf(1.f - fexp(2.f * la), 0.f)) * (ig * xcf[row * 128 + ch]);
            }
            const int o = (dir * 128 + ch) * 68 + mi * 32 + 8 * g4 + 4 * hh;
            uint2 l2, u2;
            l2.x = pack2(lq[0], lq[1]); l2.y = pack2(lq[2], lq[3]);
            u2.x = pack2(uq[0], uq[1]); u2.y = pack2(uq[2], uq[3]);
            *(uint2*)(la_s + o) = l2;
            *(uint2*)(u_s + o) = u2;
          }
      }
    }
    __syncthreads();
    {
      const size_t tile = (size_t)(rowof(seq, t0) >> 6);
#pragma unroll
      for (int i = 0; i < 8; ++i) {
        const int cc = tid + 512 * i;
        const int arr = cc >> 10, rem = cc & 1023, chh = rem >> 3, tk = rem & 7;
        const int dirr = arr & 1, isu = arr >> 1;
        const u16* src = (isu ? u_s : la_s) + (dirr * 128 + chh) * 68 + tk * 8;
        u16* dst = (isu ? LU : LA) + (((size_t)dirr * 520 + tile) * 512 + nblk * 128 + chh) * 64 + tk * 8;
        const uint2 lo = *(const uint2*)(src), hi = *(const uint2*)(src + 4);
        *(uint4*)dst = make_uint4(lo.x, lo.y, hi.x, hi.y);
      }
    }
    if (tid < 256) {
      const int dirr = tid >> 7, ch = tid & 127;
      const u16* lp = la_s + (dirr * 128 + ch) * 68;
      const u16* up = u_s + (dirr * 128 + ch) * 68;
      float hloc = 0.f, las = 0.f;
      if (dirr == 0) {
#pragma unroll
        for (int q = 0; q < 16; ++q) {
          const uint2 l2 = *(const uint2*)(lp + q * 4), u2 = *(const uint2*)(up + q * 4);
          const float lf[4] = {lo2f(l2.x), hi2f(l2.x), lo2f(l2.y), hi2f(l2.y)};
          const float uf[4] = {lo2f(u2.x), hi2f(u2.x), lo2f(u2.y), hi2f(u2.y)};
#pragma unroll
          for (int j = 0; j < 4; ++j) { hloc = fexp(lf[j]) * hloc + uf[j]; las += lf[j]; }
        }
      } else {
#pragma unroll
        for (int q = 15; q >= 0; --q) {
          const uint2 l2 = *(const uint2*)(lp + q * 4), u2 = *(const uint2*)(up + q * 4);
          const float lf[4] = {lo2f(l2.x), hi2f(l2.x), lo2f(l2.y), hi2f(l2.y)};
          const float uf[4] = {lo2f(u2.x), hi2f(u2.x), lo2f(u2.y), hi2f(u2.y)};
#pragma unroll
          for (int j = 3; j >= 0; --j) { hloc = fexp(lf[j]) * hloc + uf[j]; las += lf[j]; }
        }
      }
      if (dirr == 0) Uacc = fexp(las) * Uacc + hloc;
      else Uacc = Uacc + fexp(LAacc) * hloc;
      LAacc += las;
    }
    __syncthreads();
  }
  if (tid0 < 256) {
    const int dirr = tid0 >> 7, ch = tid0 & 127;
    const int pidx = dirr == 0 ? sidx : (sidx < 2 ? 1 - sidx : 131 - sidx);
    const size_t idx = ((size_t)(dirr * 2 + b) * 130 + pidx) * 512 + nblk * 128 + ch;
    LSA[idx] = LAacc;
    LSU[idx] = Uacc;
  }
}

__device__ __forceinline__ void lru_final_item(const P& p, int b, int sidx) {
  const int ch = opq_tid();
  const u16* Z = (const u16*)(p.ws + OFF_Z);
  u16* Y = (u16*)(p.ws + OFF_HY);
  const u16* LA = (const u16*)(p.ws + OFF_LA);
  const u16* LU = (const u16*)(p.ws + OFF_LU);
  const float* LSU = (const float*)(p.ws + OFF_LSU);
  int seq, tbase;
  if (sidx < 2) { seq = 2 + b; tbase = sidx * 128; }
  else { seq = b; tbase = (sidx - 2) * 128; }
  const int grow0 = rowof(seq, tbase);
  const size_t tile0 = (size_t)(grow0 >> 6);
  const int p_fw = sidx, p_bw = sidx < 2 ? 1 - sidx : 131 - sidx;
  unsigned hbp[64];
  {
    float h = LSU[((size_t)(2 + b) * 130 + p_bw) * 512 + ch];
#pragma unroll
    for (int tl = 1; tl >= 0; --tl) {
      const uint4* lp = (const uint4*)(LA + (((size_t)520 + tile0 + tl) * 512 + ch) * 64);
      const uint4* up = (const uint4*)(LU + (((size_t)520 + tile0 + tl) * 512 + ch) * 64);
      uint4 lv[8], uv[8];
#pragma unroll
      for (int q = 0; q < 8; ++q) { lv[q] = lp[q]; uv[q] = up[q]; }
#pragma unroll
      for (int q = 7; q >= 0; --q) {
        float lf[8], uf[8];
        unpack8(lv[q], lf);
        unpack8(uv[q], uf);
#pragma unroll
        for (int j = 7; j >= 0; j -= 2) {
          h = fexp(lf[j]) * h + uf[j];
          const float h1 = h;
          h = fexp(lf[j - 1]) * h + uf[j - 1];
          hbp[(tl * 64 + q * 8 + j) >> 1] = pack2(h, h1);
        }
      }
    }
  }
  {
    float h = LSU[((size_t)(b) * 130 + p_fw) * 512 + ch];
    const u16* gp = Z + (size_t)grow0 * ZW + 2080 + ch;
    u16* yp = Y + (size_t)grow0 * 1024 + 512 + ch;
#pragma unroll
    for (int tl = 0; tl < 2; ++tl) {
      const uint4* lp = (const uint4*)(LA + ((tile0 + tl) * 512 + ch) * 64);
      const uint4* up = (const uint4*)(LU + ((tile0 + tl) * 512 + ch) * 64);
      uint4 lv[8], uv[8];
#pragma unroll
      for (int q = 0; q < 8; ++q) { lv[q] = lp[q]; uv[q] = up[q]; }
#pragma unroll
      for (int q = 0; q < 8; ++q) {
        float lf[8], uf[8];
        unpack8(lv[q], lf);
        unpack8(uv[q], uf);
        u16 g[8];
#pragma unroll
        for (int j = 0; j < 8; ++j) g[j] = gp[(size_t)(tl * 64 + q * 8 + j) * ZW];
#pragma unroll
        for (int j = 0; j < 8; ++j) {
          const int t = tl * 64 + q * 8 + j;
          h = fexp(lf[j]) * h + uf[j];
          const unsigned hp = hbp[t >> 1];
          const float hb = (t & 1) ? hi2f(hp) : lo2f(hp);
          yp[(size_t)t * 1024] = f2bf((h + hb) * siluf_(bf2f(g[j])));
        }
      }
    }
  }
}

__device__ __forceinline__ void attn_item(const P& p, int jl, bool isctx, int b, int qb, int kvh, char* lds) {
  const int tid = opq_tid(), lane = tid & 63, w = tid >> 6, r = lane & 31, hh = lane >> 5;
  u16* K_s = (u16*)(lds);
  u16* V_s = (u16*)(lds + 9216);
  u16* Pw = (u16*)(lds + 21504) + w * 64 * 72;
  const int trv = tr_lane_off(lane, 96);
  const u16* Z = (const u16*)(p.ws + OFF_Z);
  u16* Y = (u16*)(p.ws + OFF_HY);
  const int g = w >> 1, half = w & 1, qh = kvh * 4 + g;
  const int qseq = isctx ? 2 + b : b;
  const int t0 = qb * 128;
  bf16x8 qf[2][4];
#pragma unroll
  for (int n = 0; n < 2; ++n) {
    const int qrow = rowof(qseq, t0 + half * 64 + n * 32 + r);
#pragma unroll
    for (int ks = 0; ks < 4; ++ks) qf[n][ks] = *(const bf16x8*)(Z + (size_t)qrow * ZW + qh * 64 + ks * 16 + hh * 8);
  }
  const float sink = p.in[27][jl * 8 + qh];
  float m[2] = {sink, sink};
  float l[2] = {hh == 0 ? 1.f : 0.f, hh == 0 ? 1.f : 0.f};
  f32x16 accO[2][2];
#pragma unroll
  for (int a = 0; a < 2; ++a)
#pragma unroll
    for (int n = 0; n < 2; ++n) accO[a][n] = zero16();
  int ilo = 0, ihi = 0;
  if (!isctx) { ilo = t0 >= 128 ? 0 : 2; ihi = (t0 + 256 <= L) ? 6 : 4; }
  const int nlat = ihi - ilo, ntiles = nlat + 4;
  const int tqlo = t0 + half * 64;
  uint4 kvr, vvr;
  auto issue_kv = [&](int j) {
    const int key = tid >> 3, c8 = (tid & 7) * 8;
    const int row = (j < nlat) ? rowof(b, t0 - 128 + 64 * (ilo + j) + key) : rowof(2 + b, (j - nlat) * 64 + key);
    const u16* zr = Z + (size_t)row * ZW;
    kvr = *(const uint4*)(zr + 512 + kvh * 64 + c8);
    vvr = *(const uint4*)(zr + 640 + kvh * 64 + c8);
  };
  issue_kv(0);
  for (int ti = 0; ti < ntiles; ++ti) {
    const bool lat = ti < nlat;
    const int kt = lat ? t0 - 128 + 64 * (ilo + ti) : (ti - nlat) * 64;
    const bool skip = lat && (kt - (tqlo + 63) > 128 || kt + 63 - tqlo < -128);
    const bool masked = lat && (kt + 63 - tqlo > 128 || kt - (tqlo + 63) < -128);
    {
      const int key = tid >> 3, c8 = (tid & 7) * 8;
      *(uint4*)(K_s + key * 72 + c8) = kvr;
      *(uint4*)(V_s + key * 96 + c8) = vvr;
    }
    if (ti + 1 < ntiles) issue_kv(ti + 1);
    __syncthreads();
    if (!skip) {
    f32x16 s[2][2];
#pragma unroll
    for (int a = 0; a < 2; ++a)
#pragma unroll
      for (int n = 0; n < 2; ++n) s[a][n] = zero16();
#pragma unroll
    for (int ks = 0; ks < 4; ++ks) {
      const bf16x8 a0 = LDS8(K_s + r * 72 + ks * 16 + hh * 8);
      const bf16x8 a1 = LDS8(K_s + (32 + r) * 72 + ks * 16 + hh * 8);
      s[0][0] = mfma32(a0, qf[0][ks], s[0][0]);
      s[0][1] = mfma32(a0, qf[1][ks], s[0][1]);
      s[1][0] = mfma32(a1, qf[0][ks], s[1][0]);
      s[1][1] = mfma32(a1, qf[1][ks], s[1][1]);
    }
    if (masked) {
#pragma unroll
      for (int mk = 0; mk < 2; ++mk)
#pragma unroll
        for (int n = 0; n < 2; ++n)
#pragma unroll
          for (int i = 0; i < 16; ++i) {
            const int kp = kt + mk * 32 + 8 * (i >> 2) + 4 * hh + (i & 3);
            const int dl = kp - (tqlo + n * 32 + r);
            if (dl > 128 || dl < -128) s[mk][n][i] = -1e30f;
          }
    }
#pragma unroll
    for (int n = 0; n < 2; ++n) {
      float mx = -1e30f;
#pragma unroll
      for (int mk = 0; mk < 2; ++mk)
#pragma unroll
        for (int i = 0; i < 16; ++i) mx = fmaxf(mx, s[mk][n][i]);
      mx = fmaxf(mx, __shfl_xor(mx, 32));
      const float mn = fmaxf(m[n], mx);
      const float alpha = fexp(m[n] - mn);
      m[n] = mn;
      float ls = 0.f;
#pragma unroll
      for (int mk = 0; mk < 2; ++mk)
#pragma unroll
        for (int i = 0; i < 16; ++i) {
          const float pv = fexp(s[mk][n][i] - mn);
          s[mk][n][i] = pv;
          ls += pv;
        }
      l[n] = l[n] * alpha + ls;
#pragma unroll
      for (int mv = 0; mv < 2; ++mv)
#pragma unroll
        for (int i = 0; i < 16; ++i) accO[mv][n][i] *= alpha;
#pragma unroll
      for (int mk = 0; mk < 2; ++mk)
#pragma unroll
        for (int g4 = 0; g4 < 4; ++g4) {
          uint2 s2;
          s2.x = pack2(s[mk][n][4 * g4], s[mk][n][4 * g4 + 1]);
          s2.y = pack2(s[mk][n][4 * g4 + 2], s[mk][n][4 * g4 + 3]);
          *(uint2*)(Pw + (n * 32 + r) * 72 + mk * 32 + 8 * g4 + 4 * hh) = s2;
        }
    }
    }
    __syncthreads();
    if (!skip) {
#pragma unroll
    for (int ks = 0; ks < 4; ++ks) {
      const bf16x8 b0 = LDS8(Pw + r * 72 + ks * 16 + hh * 8);
      const bf16x8 b1 = LDS8(Pw + (32 + r) * 72 + ks * 16 + hh * 8);
      const bf16x8 a0 = tr_frag(V_s, 96, ks, 0, trv);
      const bf16x8 a1 = tr_frag(V_s, 96, ks, 1, trv);
      accO[0][0] = mfma32(a0, b0, accO[0][0]);
      accO[0][1] = mfma32(a0, b1, accO[0][1]);
      accO[1][0] = mfma32(a1, b0, accO[1][0]);
      accO[1][1] = mfma32(a1, b1, accO[1][1]);
    }
    }
    __syncthreads();
  }
#pragma unroll
  for (int n = 0; n < 2; ++n) {
    const float lt = l[n] + __shfl_xor(l[n], 32);
    const float inv = __builtin_amdgcn_rcpf(lt);
    const int qrow = rowof(qseq, t0 + half * 64 + n * 32 + r);
    const u16* gp = Z + (size_t)qrow * ZW + 768 + qh * 64;
    u16* yp = Y + (size_t)qrow * 1024 + qh * 64;
#pragma unroll
    for (int mv = 0; mv < 2; ++mv)
#pragma unroll
      for (int g4 = 0; g4 < 4; ++g4) {
        const int v0 = mv * 32 + 8 * g4 + 4 * hh;
        const uint2 gv = *(const uint2*)(gp + v0);
        const float o0 = accO[mv][n][4 * g4] * inv * siluf_(lo2f(gv.x));
        const float o1 = accO[mv][n][4 * g4 + 1] * inv * siluf_(hi2f(gv.x));
        const float o2 = accO[mv][n][4 * g4 + 2] * inv * siluf_(lo2f(gv.y));
        const float o3 = accO[mv][n][4 * g4 + 3] * inv * siluf_(hi2f(gv.y));
        uint2 ov;
        ov.x = pack2(o0, o1); ov.y = pack2(o2, o3);
        *(uint2*)(yp + v0) = ov;
      }
  }
}

__device__ __forceinline__ void make_cfg(const P& p, int l, MixCfg& c) {
  const int jl = l >> 1;
  if ((l & 1) == 0) {
    c.qcol = 0; c.kcol = 256; c.vcol = 512; c.gcol = 1024; c.ycol = 0; c.lrcol = 1536; c.ret = 0; c.pad = 0;
    c.up0 = p.in[8] + jl * 16 * 256; c.up1 = p.in[10] + jl * 16 * 256;
    c.ub0 = p.in[9] + jl * 256; c.ub1 = p.in[11] + jl * 256;
    c.dec0 = p.in[28]; c.dec1 = p.in[29];
    c.ng = p.in[12] + jl * 128;
  } else {
    c.qcol = 1280; c.kcol = 1536; c.vcol = 1792; c.gcol = 2304; c.ycol = 512; c.lrcol = 0; c.ret = 1; c.pad = 0;
    c.up0 = p.in[8]; c.up1 = p.in[10];
    c.ub0 = p.in[9]; c.ub1 = p.in[11];
    c.dec0 = p.in[28] + jl * 4; c.dec1 = p.in[29] + jl * 4;
    c.ng = p.in[30] + jl * 128;
  }
}

__device__ __forceinline__ void phase_mix1(const P& p, int l, char* lds) {
  MixCfg c;
  make_cfg(p, l, c);
  const int jl = l >> 1;
  const bool odd = (l & 1) != 0;
  const int G = gridDim.x;
  if (odd) {
    for (int rp = 0; rp < ((PROBE_REP & 0x100) ? 2 : 1); ++rp)
    for (int it = blockIdx.x; it < 512; it += G) attn_item(p, jl, false, it >> 8, (it >> 1) & 127, it & 1, lds);
  } else {
    const int vb = (blockIdx.x + G - 16) % G;
    for (int rp = 0; rp < ((PROBE_REP & 0x200) ? 2 : 1); ++rp)
    for (int it = vb; it < 1040; it += G) {
      int bb, sidx, nblk;
      if (it < 1024) { nblk = it & 3; sidx = 2 + ((it >> 2) & 127); bb = it >> 9; }
      else { const int j = it - 1024; nblk = j & 3; sidx = (j >> 2) & 1; bb = j >> 3; }
      lru_coeff_item(p, jl, bb, sidx, nblk, lds);
    }
  }
  {
    const int vb = (blockIdx.x + G - 40) % G;
    for (int rp = 0; rp < ((PROBE_REP & 0x400) ? 2 : 1); ++rp)
    for (int it = vb; it < 552; it += G) {
      if (it < 512) {
        const int seg = it & 63, rest = it >> 6;
        gla_passA(p, c, rest >> 2, rest & 3, rest >> 2, seg * 256, seg + 1, 64 - seg, lds);
      } else if (it < 520) {
        const int j = it - 512;
        gla_passA(p, c, j >> 2, j & 3, 2 + (j >> 2), 0, 0, 0, lds);
      } else {
        const int j = it - 520, k = j & 3, bh = j >> 2;
        gla_dir_pass(p, c, bh >> 2, bh & 3, 1, 0, lds, true, false, k + 1, k, false);
      }
    }
  }
}

__device__ __forceinline__ void phase_scan(const P& p, int l, char* lds) {
  float* GS = (float*)(p.ws + OFF_GS);
  const float* GD = (const float*)(p.ws + OFF_GD);
  const int tid = opq_tid();
  for (int gidx = blockIdx.x * 512 + tid; gidx < 16 * 8192; gidx += gridDim.x * 512) {
    const int combo = gidx >> 13, e = gidx & 8191;
    float* gs = GS + (size_t)combo * 65 * 8192 + e;
    const float* gd = GD + (size_t)combo * 65 * 64 + (e >> 7);
    float S = 0.f;
#pragma unroll 1
    for (int q0 = 0; q0 < 65; q0 += 13) {
      float ev[13], dd[13];
#pragma unroll
      for (int q = 0; q < 13; ++q) { ev[q] = gs[(size_t)(q0 + q) * 8192]; dd[q] = gd[(q0 + q) * 64]; }
#pragma unroll
      for (int q = 0; q < 13; ++q) {
        gs[(size_t)(q0 + q) * 8192] = S;
        S = dd[q] * S + ev[q];
      }
    }
  }
  if ((l & 1) == 0) {
    const float* LSA = (const float*)(p.ws + OFF_LSA);
    float* LSU = (float*)(p.ws + OFF_LSU);
    for (int gidx = blockIdx.x * 512 + tid; gidx < 2048; gidx += gridDim.x * 512) {
      const int combo = gidx >> 9, ch = gidx & 511;
      const float* pa = LSA + (size_t)combo * 130 * 512 + ch;
      float* pu = LSU + (size_t)combo * 130 * 512 + ch;
      float hin = 0.f;
#pragma unroll 1
      for (int q0 = 0; q0 < 130; q0 += 13) {
        float la[13], u[13];
#pragma unroll
        for (int q = 0; q < 13; ++q) { la[q] = pa[(q0 + q) * 512]; u[q] = pu[(q0 + q) * 512]; }
#pragma unroll
        for (int q = 0; q < 13; ++q) {
          pu[(q0 + q) * 512] = hin;
          hin = fexp(la[q]) * hin + u[q];
        }
      }
    }
  }
  {
    MixCfg c;
    make_cfg(p, l, c);
    const int G = gridDim.x;
    const int vb = (blockIdx.x + G - 64) % G;
    for (int it = vb; it < 32; it += G) {
      const int k = it & 3, bh = it >> 2;
      gla_dir_pass(p, c, bh >> 2, bh & 3, 0, 0, lds, true, true, k + 1, k, false);
    }
    if (l & 1) {
      const int vb2 = (blockIdx.x + G - 128) % G;
      for (int it = vb2; it < 8; it += G) attn_item(p, l >> 1, true, it >> 2, (it >> 1) & 1, it & 1, lds);
    }
  }
}

__device__ __forceinline__ void phase_mix2(const P& p, int l, char* lds) {
  MixCfg c;
  make_cfg(p, l, c);
  const bool odd = (l & 1) != 0;
  const int G = gridDim.x;
  for (int rp = 0; rp < ((PROBE_REP & 0x800) ? 2 : 1); ++rp)
  for (int it = blockIdx.x; it < 512; it += G) {
    const int sidx = 1 + (it & 63), rest = it >> 6;
    const int h = rest & 3, b = rest >> 2;
    for (int dd = 1; dd >= 0; --dd) gla_dir_pass(p, c, b, h, dd, dd ? 65 - sidx : sidx, lds, true, dd == 0, 4, 0, false);
  }
  if (!odd) {
    const int vb = (blockIdx.x + G - 64) % G;
    for (int it = vb; it < 260; it += G) {
      if (it < 256) lru_final_item(p, it >> 7, 2 + (it & 127));
      else lru_final_item(p, (it - 256) >> 1, (it - 256) & 1);
    }
  }
}

__device__ __forceinline__ void grid_barrier(unsigned* ctr, unsigned target) {
  asm volatile("s_waitcnt vmcnt(0)" ::: "memory");
  __syncthreads();
  if (threadIdx.x == 0) {
    __builtin_amdgcn_fence(__ATOMIC_RELEASE, "agent");
    asm volatile("s_waitcnt vmcnt(0)" ::: "memory");
    __hip_atomic_fetch_add(ctr, 1u, __ATOMIC_RELAXED, __HIP_MEMORY_SCOPE_AGENT);
    unsigned sp = 0;
    while (__hip_atomic_load(ctr, __ATOMIC_RELAXED, __HIP_MEMORY_SCOPE_AGENT) < target) {
      __builtin_amdgcn_s_sleep(1);
      if (++sp > (1u << 24)) break;
    }
    __builtin_amdgcn_fence(__ATOMIC_ACQUIRE, "agent");
    asm volatile("s_waitcnt vmcnt(0)" ::: "memory");
  }
  __syncthreads();
}

__global__ void __launch_bounds__(512) fwd_megakernel(P p) {
  extern __shared__ __attribute__((aligned(16))) char lds[];
  const int ph_lo = p.ph_lo, ph_hi = p.ph_hi;
  unsigned nbar = 0;
  unsigned* bar_ctr = (unsigned*)(p.ws + OFF_BAR);
  for (int i = 0; i < PROBE_SYNC; ++i) { ++nbar; grid_barrier(bar_ctr, nbar * gridDim.x); }
  for (int ph = ph_lo; ph < ph_hi; ++ph) {
    int reps = 1;
    if (PROBE_REP) {
      const int l = (ph - 1) / 6, s = (ph - 1) % 6;
      if (ph == 0) { if (PROBE_REP & 64) reps = 2; }
      else if (ph < NPH - 1 && s != 3 && (s != 5 || l == 0) && ((PROBE_REP >> s) & 1)) reps = 2;
    }
    for (int rep = 0; rep < reps; ++rep) {
    if (ph > ph_lo || rep > 0) {
      if (ph == ph_lo + 1 && rep == 0) cg::this_grid().sync();
      else { ++nbar; grid_barrier(bar_ctr, nbar * gridDim.x); }
    }
    size_t z = 0;
    asm volatile("" : "+s"(z));
    const P& q = *(const P*)((const __attribute__((address_space(4))) char*)__builtin_amdgcn_kernarg_segment_ptr() + z);
    char* ldsq = lds + z;
    if (ph == 0) phase_prep(q, ldsq);
    else if (ph == NPH - 1) phase_final(q);
    else {
      const int l = (ph - 1) / 6, s = (ph - 1) % 6;
      if (s == 0) phase_norm(q, l);
      else if (s == 1) phase_gemm_in(q, l, ldsq);
      else if (s == 2) phase_mix1(q, l, ldsq);
      else if (s == 3) phase_scan(q, l, ldsq);
      else if (s == 4) phase_mix2(q, l, ldsq);
      else phase_gemm_out(q, l, ldsq);
    }
    }
  }
}

extern "C" void kernel_launch(void* const* d_in, const int* in_sizes, int n_in, void* d_out, int out_size,
                              void* d_ws, size_t ws_size, hipStream_t stream) {
  static int grid = 0;
  if (grid == 0) {
    if (n_in != 33 || ws_size < WS_END) {
      fprintf(stderr, "kernel_launch: unexpected n_in %d or ws_size %zu (< %zu)\n", n_in, ws_size, (size_t)WS_END);
      grid = -1;
      return;
    }
    int dev = 0, cus = 0;
    hipGetDevice(&dev);
    hipDeviceGetAttribute(&cus, hipDeviceAttributeMultiprocessorCount, dev);
    if (hipFuncSetAttribute((const void*)fwd_megakernel, hipFuncAttributeMaxDynamicSharedMemorySize, LDS_BYTES) != hipSuccess) {
      fprintf(stderr, "kernel_launch: hipFuncSetAttribute failed\n");
      grid = -1;
      return;
    }
    int per_cu = 0;
    hipOccupancyMaxActiveBlocksPerMultiprocessor(&per_cu, (const void*)fwd_megakernel, 512, LDS_BYTES);
    (void)hipGetLastError();
    if (per_cu < 1) fprintf(stderr, "kernel_launch: occupancy query says %d blocks per CU\n", per_cu);
    grid = cus > 0 ? cus : 256;
  }
  if (grid < 0) return;
  P p{};
  for (int i = 0; i < 33; ++i) p.in[i] = (const float*)d_in[i];
  p.out = (float*)d_out;
  p.ws = (char*)d_ws;
#if MK_COOP
  if (hipMemsetAsync((char*)d_ws + OFF_BAR, 0, 256, stream) != hipSuccess) { fprintf(stderr, "kernel_launch: memset of barrier words failed\n"); return; }
  p.ph_lo = 0; p.ph_hi = NPH;
  void* args[] = {&p};
  hipError_t e = hipLaunchCooperativeKernel((const void*)fwd_megakernel, dim3(grid), dim3(512), args, LDS_BYTES, stream);
  if (e != hipSuccess) fprintf(stderr, "cooperative launch failed: %s (grid %d)\n", hipGetErrorString(e), grid);
#else
  for (int ph = 0; ph < NPH; ++ph) {
    p.ph_lo = ph; p.ph_hi = ph + 1;
    hipLaunchKernelGGL(fwd_megakernel, dim3(grid), dim3(512), LDS_BYTES, stream, p);
  }
#endif
}
```

```cpp
#include <hip/hip_runtime.h>
#include <hip/hip_cooperative_groups.h>
#include <cstdio>
namespace cg = cooperative_groups;

#ifndef MK_COOP
#define MK_COOP 1
#endif
#ifndef PROBE_REP
#define PROBE_REP 0
#endif
#ifndef PROBE_SYNC
#define PROBE_SYNC 0
#endif

typedef unsigned short u16;
typedef __attribute__((ext_vector_type(8))) short bf16x8;
typedef __attribute__((ext_vector_type(16))) float f32x16;

constexpr int D = 1024, NB = 2, L = 16384, LC = 256;
constexpr int NLAT = NB * L, NCTX = NB * LC, NROW = NLAT + NCTX;
constexpr int ZW = 2816;
constexpr int NPH = 26;
constexpr int LDS_BYTES = 163840;

constexpr size_t OFF_Z    = 0;
constexpr size_t OFF_HY   = OFF_Z + (size_t)NROW * ZW * 2;
constexpr size_t OFF_WIN  = OFF_HY + (size_t)NROW * 1024 * 2;
constexpr size_t OFF_WOUT = OFF_WIN + (size_t)4 * 2816 * 1024 * 2;
constexpr size_t OFF_WLRU = OFF_WOUT + (size_t)4 * 1024 * 1024 * 2;
constexpr size_t OFF_LA   = OFF_WLRU + (size_t)2 * 4 * 4 * 16384 * 2;
constexpr size_t OFF_LU   = OFF_LA + (size_t)2 * NROW * 512 * 2;
constexpr size_t OFF_GS   = OFF_LU + (size_t)2 * NROW * 512 * 2;
constexpr size_t OFF_GD   = OFF_GS + (size_t)16 * 65 * 8192 * 4;
constexpr size_t OFF_LSA  = OFF_GD + (size_t)16 * 65 * 64 * 4;
constexpr size_t OFF_LSU  = OFF_LSA + (size_t)4 * 130 * 512 * 4;
constexpr size_t OFF_MOD  = OFF_LSU + (size_t)4 * 130 * 512 * 4;
constexpr size_t OFF_CTXX = OFF_MOD + (size_t)4 * 3 * 3072 * 4;
constexpr size_t OFF_ROPE = OFF_CTXX + (size_t)NCTX * 1024 * 4;
constexpr size_t OFF_BAR  = OFF_ROPE + (size_t)256 * 16 * 8;
constexpr size_t WS_END   = OFF_BAR + 256;

struct P {
  const float* in[33];
  float* out;
  char* ws;
  int ph_lo, ph_hi;
};

struct MixCfg {
  int qcol, kcol, vcol, gcol, ycol, lrcol, ret, pad;
  const float* up0; const float* up1;
  const float* ub0; const float* ub1;
  const float* dec0; const float* dec1;
  const float* ng;
};

typedef __attribute__((ext_vector_type(2))) float f32x2_t;
typedef __attribute__((ext_vector_type(2))) __bf16 bf16x2_t;
__device__ __forceinline__ unsigned pack2(float a, float b) {
  f32x2_t f; f[0] = a; f[1] = b;
  return __builtin_bit_cast(unsigned, __builtin_convertvector(f, bf16x2_t));
}
__device__ __forceinline__ u16 f2bf(float f) { return (u16)(pack2(f, 0.f) & 0xffffu); }
__device__ __forceinline__ float bf2f(u16 h) { return __uint_as_float(((unsigned)h) << 16); }
__device__ __forceinline__ float lo2f(unsigned u) { return __uint_as_float(u << 16); }
__device__ __forceinline__ float hi2f(unsigned u) { return __uint_as_float(u & 0xffff0000u); }
__device__ __forceinline__ void unpack8(const uint4& v, float* f) {
  f[0] = lo2f(v.x); f[1] = hi2f(v.x); f[2] = lo2f(v.y); f[3] = hi2f(v.y);
  f[4] = lo2f(v.z); f[5] = hi2f(v.z); f[6] = lo2f(v.w); f[7] = hi2f(v.w);
}
__device__ __forceinline__ uint4 pack8(const float* f) {
  uint4 v; v.x = pack2(f[0], f[1]); v.y = pack2(f[2], f[3]); v.z = pack2(f[4], f[5]); v.w = pack2(f[6], f[7]); return v;
}
__device__ __forceinline__ int opq_tid() { int t = threadIdx.x; asm volatile("" : "+v"(t)); return t; }
__device__ __forceinline__ float fexp(float x) { return __builtin_amdgcn_exp2f(x * 1.4426950408889634f); }
__device__ __forceinline__ float flog(float x) { return __builtin_amdgcn_logf(x) * 0.6931471805599453f; }
__device__ __forceinline__ float sigmoidf_(float x) { return __builtin_amdgcn_rcpf(1.f + fexp(-x)); }
__device__ __forceinline__ float siluf_(float x) { return x * __builtin_amdgcn_rcpf(1.f + fexp(-x)); }
__device__ __forceinline__ float logsigf_(float x) { return fminf(x, 0.f) - flog(1.f + fexp(-fabsf(x))); }
__device__ __forceinline__ int rowof(int seq, int t) { return seq < 2 ? seq * L + t : NLAT + (seq - 2) * LC + t; }
__device__ __forceinline__ f32x16 mfma32(bf16x8 a, bf16x8 b, f32x16 c) {
  return __builtin_amdgcn_mfma_f32_32x32x16_bf16(a, b, c, 0, 0, 0);
}
typedef __attribute__((ext_vector_type(4))) float f32x4;
__device__ __forceinline__ f32x4 mfma16(bf16x8 a, bf16x8 b, f32x4 c) {
  return __builtin_amdgcn_mfma_f32_16x16x32_bf16(a, b, c, 0, 0, 0);
}
__device__ __forceinline__ f32x16 zero16() {
  f32x16 z;
#pragma unroll
  for (int i = 0; i < 16; ++i) z[i] = 0.f;
  return z;
}
#define LDS8(ptr) (*(const bf16x8*)(ptr))
typedef __attribute__((ext_vector_type(4))) short s16x4;
__device__ __forceinline__ int tr_lane_off(int lane, int stride) {
  return (8 * (lane >> 5) + ((lane & 15) >> 2)) * stride + 16 * ((lane >> 4) & 1) + 4 * (lane & 3);
}
__device__ __forceinline__ bf16x8 tr_frag(const u16* T, int stride, int ks, int c, int loff) {
  const u16* a0 = T + loff + 16 * ks * stride + 32 * c;
  const s16x4 lo = __builtin_amdgcn_ds_read_tr16_b64_v4i16((__attribute__((address_space(3))) s16x4*)(a0));
  const s16x4 hi = __builtin_amdgcn_ds_read_tr16_b64_v4i16((__attribute__((address_space(3))) s16x4*)(a0 + 4 * stride));
  bf16x8 f;
  f[0] = lo[0]; f[1] = lo[1]; f[2] = lo[2]; f[3] = lo[3]; f[4] = hi[0]; f[5] = hi[1]; f[6] = hi[2]; f[7] = hi[3];
  return f;
}

__device__ __forceinline__ void transpose_tile(const float* __restrict__ src, int ldsrc, int nvalid, int n0, int k0,
                               u16* __restrict__ dst, int lddst, int scale_mode, char* lds) {
  float* ts = (float*)lds;
  const int tid = opq_tid();
  {
    const int k = tid >> 3, n8 = (tid & 7) * 8;
    float v[8];
    if (n0 + n8 < nvalid) {
      const float4 a = *(const float4*)(src + (size_t)(k0 + k) * ldsrc + n0 + n8);
      const float4 b = *(const float4*)(src + (size_t)(k0 + k) * ldsrc + n0 + n8 + 4);
      v[0] = a.x; v[1] = a.y; v[2] = a.z; v[3] = a.w; v[4] = b.x; v[5] = b.y; v[6] = b.z; v[7] = b.w;
    } else {
#pragma unroll
      for (int j = 0; j < 8; ++j) v[j] = 0.f;
    }
#pragma unroll
    for (int j = 0; j < 8; ++j) {
      const int n = n0 + n8 + j;
      float x = v[j];
      if (scale_mode == 1) { if (n < 256) x *= 0.125f; }
      else if (scale_mode == 2) { if (n < 512 || (n >= 1536 && n < 1792)) x *= 0.125f; }
      ts[k * 65 + n8 + j] = x;
    }
  }
  __syncthreads();
  {
    const int n = tid >> 3, k8 = (tid & 7) * 8;
    float f[8];
#pragma unroll
    for (int j = 0; j < 8; ++j) f[j] = ts[(k8 + j) * 65 + n];
    if (lddst > 0) *(uint4*)(dst + (size_t)(n0 + n) * lddst + k0 + k8) = pack8(f);
    else {
      const int jj = n0 + n, ii = k0 + k8;
      *(uint4*)(dst + ((((jj >> 5) * 8 + (ii >> 4)) * 64 + (jj & 31) + 32 * ((ii >> 3) & 1)) * 8)) = pack8(f);
    }
  }
  __syncthreads();
}

__device__ __forceinline__ void phase_prep(const P& p, char* lds) {
  const int tid = opq_tid();
  constexpr int T_WIN = 4 * 44 * 16, T_WOUT = 4 * 16 * 16, T_LRU = 2 * 4 * 4 * 4, T_MOD = 96;
  constexpr int TOT = T_WIN + T_WOUT + T_LRU + T_MOD + 1;
  for (int it = blockIdx.x; it < TOT; it += gridDim.x) {
    if (it < T_WIN) {
      const int l = it / 704, rem = it % 704, ntile = rem >> 4, ktile = rem & 15;
      const bool even = (l & 1) == 0;
      const float* src = even ? p.in[7] + (size_t)(l >> 1) * 1024 * 2592 : p.in[26] + (size_t)(l >> 1) * 1024 * 2816;
      transpose_tile(src, even ? 2592 : 2816, even ? 2592 : 2816, ntile * 64, ktile * 64,
                     (u16*)(p.ws + OFF_WIN) + (size_t)l * 2816 * 1024, 1024, even ? 1 : 2, lds);
    } else if (it < T_WIN + T_WOUT) {
      const int j = it - T_WIN, l = j >> 8, rem = j & 255, ntile = rem >> 4, ktile = rem & 15;
      const float* src = ((l & 1) == 0) ? p.in[25] + (size_t)(l >> 1) * 1024 * 1024 : p.in[31] + (size_t)(l >> 1) * 1024 * 1024;
      transpose_tile(src, 1024, 1024, ntile * 64, ktile * 64, (u16*)(p.ws + OFF_WOUT) + (size_t)l * 1024 * 1024, 1024, 0, lds);
    } else if (it < T_WIN + T_WOUT + T_LRU) {
      const int j = it - T_WIN - T_WOUT;
      const int t4 = j & 3, blk = (j >> 2) & 3, mat = (j >> 4) & 3, jl = j >> 6;
      const float* srcb = mat == 0 ? p.in[15] : mat == 1 ? p.in[17] : mat == 2 ? p.in[20] : p.in[22];
      const float* src = srcb + (size_t)(jl * 4 + blk) * 16384;
      u16* dst = (u16*)(p.ws + OFF_WLRU) + (size_t)((jl * 4 + mat) * 4 + blk) * 16384;
      transpose_tile(src, 128, 128, (t4 >> 1) * 64, (t4 & 1) * 64, dst, -1, 0, lds);
    } else if (it < T_WIN + T_WOUT + T_LRU + T_MOD) {
      const int j = it - T_WIN - T_WOUT - T_LRU;
      const int l = j / 24, n0 = (j % 24) * 128;
      float* sc = (float*)lds;
      float* red = (float*)(lds + 12288);
      for (int i = tid; i < 3072; i += 512) {
        const int m = i >> 10, k = i & 1023;
        const float cv = m < 2 ? p.in[1][m * 1024 + k] : p.in[3][k];
        sc[i] = siluf_(cv);
      }
      __syncthreads();
      const int cg4 = tid & 31, ks = tid >> 5;
      float acc[3][4];
#pragma unroll
      for (int m = 0; m < 3; ++m)
#pragma unroll
        for (int q = 0; q < 4; ++q) acc[m][q] = 0.f;
      const float* wp = p.in[4] + (size_t)l * 1024 * 3072 + n0 + cg4 * 4;
#pragma unroll 8
      for (int kk = 0; kk < 64; ++kk) {
        const int k = ks * 64 + kk;
        const float4 wv = *(const float4*)(wp + (size_t)k * 3072);
#pragma unroll
        for (int m = 0; m < 3; ++m) {
          const float s = sc[m * 1024 + k];
          acc[m][0] += s * wv.x; acc[m][1] += s * wv.y; acc[m][2] += s * wv.z; acc[m][3] += s * wv.w;
        }
      }
#pragma unroll
      for (int m = 0; m < 3; ++m)
#pragma unroll
        for (int q = 0; q < 4; ++q) red[(ks * 3 + m) * 128 + cg4 * 4 + q] = acc[m][q];
      __syncthreads();
      if (tid < 384) {
        const int m = tid >> 7, n = tid & 127;
        float s = 0.f;
        for (int k2 = 0; k2 < 16; ++k2) s += red[(k2 * 3 + m) * 128 + n];
        ((float*)(p.ws + OFF_MOD))[(l * 3 + m) * 3072 + n0 + n] = s + p.in[5][l * 3072 + n0 + n];
      }
      __syncthreads();
    } else {
      float2* rt = (float2*)(p.ws + OFF_ROPE);
      for (int i = tid; i < 4096; i += 512) {
        const int pos = i >> 4, f = i & 15;
        const float inv = powf(10000.f, -(float)f / 16.f);
        const float ang = (float)pos * inv;
        float s, c;
        sincosf(ang, &s, &c);
        rt[i] = make_float2(c, s);
      }
    }
  }
}

__device__ __forceinline__ const float* resid_src(const P& p, int l, int row) {
  if (row < NLAT) return (l == 0 ? p.in[0] : p.out) + (size_t)row * 1024;
  return (l == 0 ? p.in[2] : (const float*)(p.ws + OFF_CTXX)) + (size_t)(row - NLAT) * 1024;
}

__device__ __forceinline__ void phase_norm(const P& p, int l) {
  const int tid = opq_tid(), lane = tid & 63, w = tid >> 6;
  u16* H = (u16*)(p.ws + OFF_HY);
  const float* g = p.in[6] + l * 1024;
  const int stride = gridDim.x * 8;
  for (int row0 = blockIdx.x * 8 + w; row0 < NROW; row0 += 2 * stride) {
    const int row1 = row0 + stride;
    const bool has1 = row1 < NROW;
    const float* s0 = resid_src(p, l, row0);
    const float* s1 = resid_src(p, l, has1 ? row1 : row0);
    float4 v0[4], v1[4];
#pragma unroll
    for (int i = 0; i < 4; ++i) v0[i] = ((const float4*)s0)[lane + 64 * i];
#pragma unroll
    for (int i = 0; i < 4; ++i) v1[i] = ((const float4*)s1)[lane + 64 * i];
#pragma unroll
    for (int rr = 0; rr < 2; ++rr) {
      if (rr == 1 && !has1) break;
      const int row = rr ? row1 : row0;
      const int m = row < L ? 0 : (row < NLAT ? 1 : 2);
      const float* mod = (const float*)(p.ws + OFF_MOD) + (l * 3 + m) * 3072;
      float ss = 0.f;
#pragma unroll
      for (int i = 0; i < 4; ++i) {
        const float4 v = rr ? v1[i] : v0[i];
        ss += v.x * v.x + v.y * v.y + v.z * v.z + v.w * v.w;
      }
#pragma unroll
      for (int o = 32; o >= 1; o >>= 1) ss += __shfl_xor(ss, o);
      const float rstd = rsqrtf(ss * (1.f / 1024.f) + 1e-6f);
#pragma unroll
      for (int i = 0; i < 4; ++i) {
        const float4 v = rr ? v1[i] : v0[i];
        const int c = (lane + 64 * i) * 4;
        const float4 gg = *(const float4*)(g + c);
        const float4 sh = *(const float4*)(mod + c);
        const float4 sc = *(const float4*)(mod + 1024 + c);
        const float h0 = (v.x * rstd * gg.x) * (1.f + sc.x) + sh.x;
        const float h1 = (v.y * rstd * gg.y) * (1.f + sc.y) + sh.y;
        const float h2 = (v.z * rstd * gg.z) * (1.f + sc.z) + sh.z;
        const float h3 = (v.w * rstd * gg.w) * (1.f + sc.w) + sh.w;
        uint2 o2; o2.x = pack2(h0, h1); o2.y = pack2(h2, h3);
        *(uint2*)(H + (size_t)row * 1024 + c) = o2;
      }
    }
  }
}

__device__ __forceinline__ void phase_final(const P& p) {
  const int tid = opq_tid(), lane = tid & 63, w = tid >> 6;
  const float* g = p.in[32];
  const int stride = gridDim.x * 8;
  float4 gg[4];
#pragma unroll
  for (int i = 0; i < 4; ++i) gg[i] = *(const float4*)(g + (lane + 64 * i) * 4);
  for (int row0 = blockIdx.x * 8 + w; row0 < NLAT; row0 += 2 * stride) {
    const int row1 = row0 + stride;
    const bool has1 = row1 < NLAT;
    float* s0 = p.out + (size_t)row0 * 1024;
    float* s1 = p.out + (size_t)(has1 ? row1 : row0) * 1024;
    float4 v0[4], v1[4];
#pragma unroll
    for (int i = 0; i < 4; ++i) v0[i] = ((const float4*)s0)[lane + 64 * i];
#pragma unroll
    for (int i = 0; i < 4; ++i) v1[i] = ((const float4*)s1)[lane + 64 * i];
#pragma unroll
    for (int rr = 0; rr < 2; ++rr) {
      if (rr == 1 && !has1) break;
      float* dst = rr ? s1 : s0;
      float ss = 0.f;
#pragma unroll
      for (int i = 0; i < 4; ++i) {
        const float4 v = rr ? v1[i] : v0[i];
        ss += v.x * v.x + v.y * v.y + v.z * v.z + v.w * v.w;
      }
#pragma unroll
      for (int o = 32; o >= 1; o >>= 1) ss += __shfl_xor(ss, o);
      const float rstd = rsqrtf(ss * (1.f / 1024.f) + 1e-6f);
#pragma unroll
      for (int i = 0; i < 4; ++i) {
        const float4 v = rr ? v1[i] : v0[i];
        float4 o4;
        o4.x = v.x * rstd * gg[i].x; o4.y = v.y * rstd * gg[i].y; o4.z = v.z * rstd * gg[i].z; o4.w = v.w * rstd * gg[i].w;
        ((float4*)dst)[lane + 64 * i] = o4;
      }
    }
  }
}

#define WAIT_V(n) asm volatile("s_waitcnt vmcnt(" #n ")" ::: "memory")
#define WAIT_L0() asm volatile("s_waitcnt lgkmcnt(0)" ::: "memory")
constexpr int GSTG = 49152;

__device__ __forceinline__ void glds16(const u16* g, char* l) {
  __builtin_amdgcn_global_load_lds((const unsigned*)g, (__attribute__((address_space(3))) unsigned*)l, 16, 0, 0);
}
__device__ __forceinline__ void gemm_piece(const u16* __restrict__ Ag, const u16* __restrict__ Bg, int k0, char* stg, int tid, int i) {
  if (i < 4) glds16(Ag + (size_t)i * 64 * 1024 + k0, stg + tid * 16 + i * 8192);
  else glds16(Bg + (size_t)(i - 4) * 64 * 1024 + k0, stg + 32768 + tid * 16 + (i - 4) * 8192);
}

#define WAIT_VN(n) asm volatile("s_waitcnt vmcnt(%0)" ::"n"(n) : "memory")
template <bool XPF>
__device__ __forceinline__ void gemm_core(const u16* __restrict__ A, const u16* __restrict__ Bt, int m0, int n0,
                                          char* lds, f32x16 (&acc)[2][2], bool first, bool has_next, int m0n, int n0n,
                                          const float* xsrc, float4 (&xr)[16]) {
  const int tid = opq_tid(), lane = tid & 63, w = tid >> 6, r = lane & 31, hh = lane >> 5;
  const int wm = w >> 1, wn = w & 1;
#pragma unroll
  for (int mi = 0; mi < 2; ++mi)
#pragma unroll
    for (int ni = 0; ni < 2; ++ni) acc[mi][ni] = zero16();
  const int srow = tid >> 3;
  const int gch = (tid & 7) ^ ((srow >> 1) & 7);
  const u16* Ag = A + (size_t)(m0 + srow) * 1024 + gch * 8;
  const u16* Bg = Bt + (size_t)(n0 + srow) * 1024 + gch * 8;
  const int g = (r >> 1) & 7;
  const int aoff = (wm * 64 + r) * 128;
  const int boff = 32768 + (wn * 64 + r) * 128;
  int koff[4];
#pragma unroll
  for (int ks = 0; ks < 4; ++ks) koff[ks] = ((ks * 2 + hh) ^ g) * 16;
  if (first) {
    WAIT_V(0);
    __builtin_amdgcn_s_barrier();
#pragma unroll
    for (int i = 0; i < 6; ++i) gemm_piece(Ag, Bg, 0, lds, tid, i);
#pragma unroll
    for (int i = 0; i < 6; ++i) gemm_piece(Ag, Bg, 64, lds + GSTG, tid, i);
  }
  if (!XPF) {
#pragma unroll 1
    for (int kt = 0; kt < 16; ++kt) {
      if (kt == 15) WAIT_V(0);
      else if (first || kt >= 2) WAIT_V(6);
      else if (kt == 0) WAIT_V(8);
      else WAIT_V(14);
    __builtin_amdgcn_s_barrier();
      const char* st = lds + (kt % 3) * GSTG;
      char* nst = lds + ((kt + 2) % 3) * GSTG;
      const bool more = kt + 2 < 16;
      const int k2 = (kt + 2) * 64;
      bf16x8 a0 = LDS8(st + aoff + koff[0]);
      bf16x8 a1 = LDS8(st + aoff + 32 * 128 + koff[0]);
      bf16x8 b0 = LDS8(st + boff + koff[0]);
      bf16x8 b1 = LDS8(st + boff + 32 * 128 + koff[0]);
#pragma unroll
      for (int ks = 0; ks < 4; ++ks) {
        bf16x8 na0 = a0, na1 = a1, nb0 = b0, nb1 = b1;
        if (ks < 3) {
          na0 = LDS8(st + aoff + koff[ks + 1]);
          na1 = LDS8(st + aoff + 32 * 128 + koff[ks + 1]);
          nb0 = LDS8(st + boff + koff[ks + 1]);
          nb1 = LDS8(st + boff + 32 * 128 + koff[ks + 1]);
        }
        if (more) {
          if (ks == 0) { gemm_piece(Ag, Bg, k2, nst, tid, 0); gemm_piece(Ag, Bg, k2, nst, tid, 1); }
          else if (ks == 1) { gemm_piece(Ag, Bg, k2, nst, tid, 2); gemm_piece(Ag, Bg, k2, nst, tid, 3); }
          else if (ks == 2) gemm_piece(Ag, Bg, k2, nst, tid, 4);
          else gemm_piece(Ag, Bg, k2, nst, tid, 5);
        }
        acc[0][0] = mfma32(a0, b0, acc[0][0]);
        acc[0][1] = mfma32(a0, b1, acc[0][1]);
        acc[1][0] = mfma32(a1, b0, acc[1][0]);
        acc[1][1] = mfma32(a1, b1, acc[1][1]);
        a0 = na0; a1 = na1; b0 = nb0; b1 = nb1;
      }
      }
  } else {
#pragma unroll
    for (int kt = 0; kt < 16; ++kt) {
      if (kt == 0) { if (first) WAIT_V(6); else WAIT_V(16); }
      else if (kt == 1) { if (first) WAIT_V(7); else WAIT_V(23); }
      else if (kt < 15) WAIT_V(8);
      else WAIT_V(2);
    __builtin_amdgcn_s_barrier();
      const char* st = lds + (kt % 3) * GSTG;
      char* nst = lds + ((kt + 2) % 3) * GSTG;
      const bool more = kt + 2 < 16;
      const int k2 = (kt + 2) * 64;
      bf16x8 a0 = LDS8(st + aoff + koff[0]);
      bf16x8 a1 = LDS8(st + aoff + 32 * 128 + koff[0]);
      bf16x8 b0 = LDS8(st + boff + koff[0]);
      bf16x8 b1 = LDS8(st + boff + 32 * 128 + koff[0]);
#pragma unroll
      for (int ks = 0; ks < 4; ++ks) {
        bf16x8 na0 = a0, na1 = a1, nb0 = b0, nb1 = b1;
        if (ks < 3) {
          na0 = LDS8(st + aoff + koff[ks + 1]);
          na1 = LDS8(st + aoff + 32 * 128 + koff[ks + 1]);
          nb0 = LDS8(st + boff + koff[ks + 1]);
          nb1 = LDS8(st + boff + 32 * 128 + koff[ks + 1]);
        }
        if (more) {
          if (ks == 0) { gemm_piece(Ag, Bg, k2, nst, tid, 0); gemm_piece(Ag, Bg, k2, nst, tid, 1); }
          else if (ks == 1) { gemm_piece(Ag, Bg, k2, nst, tid, 2); gemm_piece(Ag, Bg, k2, nst, tid, 3); }
          else if (ks == 2) gemm_piece(Ag, Bg, k2, nst, tid, 4);
          else gemm_piece(Ag, Bg, k2, nst, tid, 5);
        }
        acc[0][0] = mfma32(a0, b0, acc[0][0]);
        acc[0][1] = mfma32(a0, b1, acc[0][1]);
        acc[1][0] = mfma32(a1, b0, acc[1][0]);
        acc[1][1] = mfma32(a1, b1, acc[1][1]);
        a0 = na0; a1 = na1; b0 = nb0; b1 = nb1;
      }
        __builtin_amdgcn_sched_barrier(0);
      {
        const int lr = (tid >> 5) + 16 * (kt & 7);
        const int row = (lr >> 5) * 64 + (kt >> 3) * 32 + (lr & 31);
        xr[kt] = *(const float4*)(xsrc + (size_t)row * 1024);
      }
      __builtin_amdgcn_sched_barrier(0);
    }
  }
  __builtin_amdgcn_s_barrier();
  if (has_next) {
    const u16* Agn = A + (size_t)(m0n + srow) * 1024 + gch * 8;
    const u16* Bgn = Bt + (size_t)(n0n + srow) * 1024 + gch * 8;
#pragma unroll
    for (int i = 0; i < 6; ++i) gemm_piece(Agn, Bgn, 0, lds, tid, i);
#pragma unroll
    for (int i = 0; i < 6; ++i) gemm_piece(Agn, Bgn, 64, lds + GSTG, tid, i);
  }
}

template <bool XPF>
__device__ __forceinline__ void gemm_core16(const u16* __restrict__ A, const u16* __restrict__ Bt, int m0, int n0,
                                          char* lds, f32x4 (&acc)[4][4], bool first, bool has_next, int m0n, int n0n,
                                          const float* xsrc, float4 (&xr)[16]) {
  const int tid = opq_tid(), lane = tid & 63, w = tid >> 6, r16 = lane & 15, q4 = lane >> 4;
  const int wm = w >> 1, wn = w & 1;
#pragma unroll
  for (int mi = 0; mi < 4; ++mi)
#pragma unroll
    for (int ni = 0; ni < 4; ++ni) { acc[mi][ni][0] = 0.f; acc[mi][ni][1] = 0.f; acc[mi][ni][2] = 0.f; acc[mi][ni][3] = 0.f; }
  const int srow = tid >> 3;
  const int gch = (tid & 7) ^ ((srow >> 1) & 7);
  const u16* Ag = A + (size_t)(m0 + srow) * 1024 + gch * 8;
  const u16* Bg = Bt + (size_t)(n0 + srow) * 1024 + gch * 8;
  const int g = (r16 >> 1) & 7;
  const int aoff = (wm * 64 + r16) * 128;
  const int boff = 32768 + (wn * 64 + r16) * 128;
  int koff[2];
#pragma unroll
  for (int ks = 0; ks < 2; ++ks) koff[ks] = ((ks * 4 + q4) ^ g) * 16;
  if (first) {
    WAIT_V(0);
    __builtin_amdgcn_s_barrier();
#pragma unroll
    for (int i = 0; i < 6; ++i) gemm_piece(Ag, Bg, 0, lds, tid, i);
#pragma unroll
    for (int i = 0; i < 6; ++i) gemm_piece(Ag, Bg, 64, lds + GSTG, tid, i);
  }
#define GEMM_KTILE_BODY                                                                               \
      __builtin_amdgcn_s_barrier();                                                                   \
      const char* st = lds + (kt % 3) * GSTG;                                                         \
      char* nst = lds + ((kt + 2) % 3) * GSTG;                                                        \
      const bool more = kt + 2 < 16;                                                                  \
      const int k2 = (kt + 2) * 64;                                                                   \
      _Pragma("unroll") for (int ks = 0; ks < 2; ++ks) {                                              \
        bf16x8 af[4];                                                                                 \
        _Pragma("unroll") for (int i = 0; i < 4; ++i) af[i] = LDS8(st + aoff + i * 2048 + koff[ks]);  \
        bf16x8 bcur = LDS8(st + boff + koff[ks]);                                                     \
        if (more) {                                                                                   \
          _Pragma("unroll") for (int i = 0; i < 3; ++i) gemm_piece(Ag, Bg, k2, nst, tid, ks * 3 + i); \
        }                                                                                             \
        _Pragma("unroll") for (int ni = 0; ni < 4; ++ni) {                                            \
          bf16x8 bnext = bcur;                                                                        \
          if (ni < 3) bnext = LDS8(st + boff + (ni + 1) * 2048 + koff[ks]);                           \
          _Pragma("unroll") for (int mi = 0; mi < 4; ++mi) acc[mi][ni] = mfma16(af[mi], bcur, acc[mi][ni]); \
          bcur = bnext;                                                                               \
        }                                                                                             \
      }
  if (!XPF) {
#pragma unroll
    for (int kt = 0; kt < 16; ++kt) {
      if (kt == 15) WAIT_V(0);
      else if (first || kt >= 2) WAIT_V(6);
      else if (kt == 0) WAIT_V(8);
      else WAIT_V(14);
      GEMM_KTILE_BODY
    }
  } else {
#pragma unroll
    for (int kt = 0; kt < 16; ++kt) {
      if (kt == 0) { if (first) WAIT_V(6); else WAIT_V(16); }
      else if (kt == 1) { if (first) WAIT_V(7); else WAIT_V(23); }
      else if (kt < 15) WAIT_V(8);
      else WAIT_V(2);
      GEMM_KTILE_BODY
      __builtin_amdgcn_sched_barrier(0);
      {
        const int lr = (tid >> 5) + 16 * (kt & 7);
        const int row = (lr >> 5) * 64 + (kt >> 3) * 32 + (lr & 31);
        xr[kt] = *(const float4*)(xsrc + (size_t)row * 1024);
      }
      __builtin_amdgcn_sched_barrier(0);
    }
  }
#undef GEMM_KTILE_BODY
  __builtin_amdgcn_s_barrier();
  if (has_next) {
    const u16* Agn = A + (size_t)(m0n + srow) * 1024 + gch * 8;
    const u16* Bgn = Bt + (size_t)(n0n + srow) * 1024 + gch * 8;
#pragma unroll
    for (int i = 0; i < 6; ++i) gemm_piece(Agn, Bgn, 0, lds, tid, i);
#pragma unroll
    for (int i = 0; i < 6; ++i) gemm_piece(Agn, Bgn, 64, lds + GSTG, tid, i);
  }
}

__device__ __forceinline__ void phase_gemm_in(const P& p, int l, char* lds) {
  const int tid = opq_tid(), lane = tid & 63, w = tid >> 6, r16 = lane & 15, q4 = lane >> 4;
  const int wm = w >> 1, wn = w & 1;
  const bool odd = (l & 1) != 0;
  const int NT = odd ? 22 : 21;
  const u16* A = (const u16*)(p.ws + OFF_HY);
  const u16* Bt = (const u16*)(p.ws + OFF_WIN) + (size_t)l * 2816 * 1024;
  u16* Z = (u16*)(p.ws + OFF_Z);
  const float rinv = powf(10000.f, -(float)r16 / 16.f);
  const int xcd = blockIdx.x & 7, slot = blockIdx.x >> 3, nslot = gridDim.x >> 3;
  const int nmt = (130 - xcd + 7) >> 3;
  bool first = true;
  for (int q = slot; q < nmt * NT; q += nslot) {
    const int mt = xcd + 8 * (q / NT), nt = q % NT;
    const int m0 = mt * 256, n0 = nt * 128;
    const int q2 = q + nslot;
    const bool has_next = q2 < nmt * NT;
    f32x4 acc[4][4];
    float4 xdummy[16];
    gemm_core16<false>(A, Bt, m0, n0, lds, acc, first, has_next, (xcd + 8 * (q2 / NT)) * 256, (q2 % NT) * 128, nullptr, xdummy);
    first = false;
    const int cb = n0 + wn * 64;
    if (odd && mt < 128 && (cb < 640 || (cb >= 1280 && cb < 1792))) {
#pragma unroll
      for (int mi = 0; mi < 4; ++mi)
#pragma unroll
        for (int j = 0; j < 4; ++j) {
          const int row = m0 + wm * 64 + mi * 16 + q4 * 4 + j;
          const int tt = row & (L - 1);
#pragma unroll
          for (int ni = 0; ni < 2; ++ni) {
            const float ang = (float)(ni == 0 ? (tt >> 6) : (tt & 63)) * rinv;
            const float sn = __sinf(ang), cn = __cosf(ang);
            const float x1 = acc[mi][ni][j], x2 = acc[mi][ni + 2][j];
            acc[mi][ni][j] = x1 * cn - x2 * sn;
            acc[mi][ni + 2][j] = x1 * sn + x2 * cn;
          }
        }
    }
    {
      u16* C_s = (u16*)(lds + 2 * GSTG);
#pragma unroll
      for (int mi = 0; mi < 4; ++mi)
#pragma unroll
        for (int ni = 0; ni < 4; ++ni)
#pragma unroll
          for (int j = 0; j < 4; ++j)
            C_s[(wm * 64 + mi * 16 + q4 * 4 + j) * 128 + wn * 64 + ni * 16 + r16] = f2bf(acc[mi][ni][j]);
      __syncthreads();
#pragma unroll
      for (int it = 0; it < 8; ++it) {
        const int cc = tid + 512 * it, row = cc >> 4, c16 = cc & 15;
        *(uint4*)(Z + (size_t)(m0 + row) * ZW + n0 + c16 * 8) = *(const uint4*)(C_s + row * 128 + c16 * 8);
      }
    }
  }
}

__device__ __forceinline__ void phase_gemm_out(const P& p, int l, char* lds) {
  const int tid = opq_tid(), lane = tid & 63, w = tid >> 6, r = lane & 31, hh = lane >> 5;
  const int wm = w >> 1, wn = w & 1;
  const u16* A = (const u16*)(p.ws + OFF_HY);
  const u16* Bt = (const u16*)(p.ws + OFF_WOUT) + (size_t)l * 1024 * 1024;
  const int MT = (l == 3) ? 128 : 130;
  const int xcd = blockIdx.x & 7, slot = blockIdx.x >> 3, nslot = gridDim.x >> 3;
  const int nmt = (MT - xcd + 7) >> 3;
  bool first = true;
  for (int q = slot; q < nmt * 8; q += nslot) {
    const int mt = xcd + 8 * (q >> 3), nt = q & 7;
    const int m0 = mt * 256, n0 = nt * 128;
    const int q2 = q + nslot;
    const bool has_next = q2 < nmt * 8;
    const int m = mt < 64 ? 0 : (mt < 128 ? 1 : 2);
    const float* gate = (const float*)(p.ws + OFF_MOD) + (l * 3 + m) * 3072 + 2048;
    const float* src; float* dst;
    if (mt < 128) { src = (l == 0 ? p.in[0] : p.out) + (size_t)m0 * 1024; dst = p.out + (size_t)m0 * 1024; }
    else { src = (l == 0 ? p.in[2] : (const float*)(p.ws + OFF_CTXX)) + (size_t)(m0 - NLAT) * 1024; dst = (float*)(p.ws + OFF_CTXX) + (size_t)(m0 - NLAT) * 1024; }
    f32x16 acc[2][2];
    float4 xr[16];
    gemm_core<true>(A, Bt, m0, n0, lds, acc, first, has_next, (xcd + 8 * (q2 >> 3)) * 256, (q2 & 7) * 128, src + n0 + (tid & 31) * 4, xr);
    first = false;
    {
      float* C_f = (float*)(lds + 2 * GSTG);
      const int c4 = (tid & 31) * 4;
      const float4 gv = *(const float4*)(gate + n0 + c4);
#pragma unroll
      for (int mi = 0; mi < 2; ++mi) {
        if (mi) __syncthreads();
#pragma unroll
        for (int ni = 0; ni < 2; ++ni)
#pragma unroll
          for (int i = 0; i < 16; ++i)
            C_f[(wm * 32 + 8 * (i >> 2) + 4 * hh + (i & 3)) * 128 + wn * 64 + ni * 32 + r] = acc[mi][ni][i];
        __syncthreads();
#pragma unroll
        for (int it = 0; it < 8; ++it) {
          const int lr = (tid >> 5) + 16 * it;
          const int row = (lr >> 5) * 64 + mi * 32 + (lr & 31);
          const float4 a4 = *(const float4*)(C_f + lr * 128 + c4);
          const size_t o = (size_t)row * 1024 + n0 + c4;
          const float4 x4 = xr[mi * 8 + it];
          float4 y4;
          y4.x = x4.x + gv.x * a4.x; y4.y = x4.y + gv.y * a4.y; y4.z = x4.z + gv.z * a4.z; y4.w = x4.w + gv.w * a4.w;
          *(float4*)(dst + o) = y4;
        }
      }
    }
  }
}

__device__ __forceinline__ void gla_dir_pass(const P& p, const MixCfg& c, int b, int h, int dir, int pidx, char* lds, const bool OUT, bool second,
                                             const int cend, const int cout_from, const bool write_state) {
  const int tid = opq_tid(), lane = tid & 63, w = tid >> 6, r = lane & 31, hh = lane >> 5;
  float* lr_s = (float*)(lds);
  float* b_s = (float*)(lds + 4096);
  float* tot_s = (float*)(lds + 20480);
  float* blast_s = (float*)(lds + 22528);
  u16* qin_s = (u16*)(lds + 22784);
  u16* kin_s = (u16*)(lds + 32000);
  u16* kst_s = (u16*)(lds + 41216);
  u16* V_s = (u16*)(lds + 53504);
  u16* St_s = (u16*)(lds + 73984);
  u16* att_s = (u16*)(lds + 92416);
  float* o_s = (float*)(lds + 101632);
  const int trk = tr_lane_off(lane, 96), trv = tr_lane_off(lane, 160);
  const u16* Z = (const u16*)(p.ws + OFF_Z);
  u16* Y = (u16*)(p.ws + OFF_HY);
  float* GS = (float*)(p.ws + OFF_GS);
  float* GD = (float*)(p.ws + OFF_GD);

  int seq, tbase;
  if (pidx == 0) { seq = 2 + b; tbase = 0; }
  else { const int seg = dir ? 64 - pidx : pidx - 1; seq = b; tbase = seg * 256; }
  const int d = tid & 63, part = tid >> 6;
  float upw[16], ubias = 0.f, lg = 0.f;
  if (!c.ret) {
#pragma unroll
    for (int rr = 0; rr < 16; ++rr) upw[rr] = (dir ? c.up1 : c.up0)[rr * 256 + h * 64 + d];
    ubias = (dir ? c.ub1 : c.ub0)[h * 64 + d];
  } else {
#pragma unroll
    for (int rr = 0; rr < 16; ++rr) upw[rr] = 0.f;
    lg = logsigf_((dir ? c.dec1 : c.dec0)[h]);
  }
  const size_t sidx = ((size_t)(dir * 2 + b) * 4 + h) * 65 + pidx;
  float* GSp = GS + sidx * 8192;
  const int mt = w >> 2, nt = w & 3;
  f32x16 accS;
  if (OUT && pidx != 0) {
#pragma unroll
    for (int i = 0; i < 16; ++i) accS[i] = GSp[(mt * 32 + 8 * (i >> 2) + 4 * hh + (i & 3)) * 128 + nt * 32 + r];
  } else {
    accS = zero16();
  }
  float sumbl = 0.f;
  uint4 lrv = make_uint4(0, 0, 0, 0), kvr, qvr = make_uint4(0, 0, 0, 0), v0r, v1r;
  uint4 o0r = make_uint4(0, 0, 0, 0), o1r = o0r, g0r = o0r, g1r = o0r;
  auto growf = [&](int cc, int row) {
    const int tbb = tbase + 64 * (dir ? 3 - cc : cc);
    return rowof(seq, dir ? tbb + 63 - row : tbb + row);
  };
  auto issue_lr = [&](int cc) {
    if (!c.ret && tid < 128)
      lrv = *(const uint4*)(Z + (size_t)growf(cc, tid >> 1) * ZW + c.lrcol + dir * 16 + (tid & 1) * 8);
  };
  auto issue_kqv = [&](int cc) {
    const u16* zr = Z + (size_t)growf(cc, tid >> 3) * ZW;
    kvr = *(const uint4*)(zr + c.kcol + h * 64 + (tid & 7) * 8);
    if (OUT) qvr = *(const uint4*)(zr + c.qcol + h * 64 + (tid & 7) * 8);
    v0r = *(const uint4*)(zr + c.vcol + h * 128 + (tid & 7) * 16);
    v1r = *(const uint4*)(zr + c.vcol + h * 128 + (tid & 7) * 16 + 8);
  };
  auto issue_epi = [&](int cc) {
    if (OUT && second) {
      const int grow = growf(cc, tid >> 3);
      const u16* yq = Y + (size_t)grow * 1024 + c.ycol + h * 128 + (tid & 7) * 16;
      o0r = *(const uint4*)(yq);
      o1r = *(const uint4*)(yq + 8);
      const u16* gq = Z + (size_t)grow * ZW + c.gcol + h * 128 + (tid & 7) * 16;
      g0r = *(const uint4*)(gq);
      g1r = *(const uint4*)(gq + 8);
    }
  };
  float ngr[16];
#pragma unroll
  for (int j = 0; j < 16; ++j) ngr[j] = (OUT && second) ? c.ng[(tid & 7) * 16 + j] : 0.f;
  issue_lr(0);
  issue_kqv(0);
  issue_epi(cout_from);
#pragma unroll 4
  for (int cidx = 0; cidx < cend; ++cidx) {
    const bool outc = OUT && cidx >= cout_from;
    const int tb = tbase + 64 * (dir ? 3 - cidx : cidx);
    if (!c.ret) {
      if (tid < 128) {
        const int row = tid >> 1, half = tid & 1;
        float f[8];
        unpack8(lrv, f);
#pragma unroll
        for (int j = 0; j < 8; ++j) lr_s[row * 16 + half * 8 + j] = f[j];
      }
      if (cidx + 1 < cend) issue_lr(cidx + 1);
      __syncthreads();
    }
    if (!c.ret) {
      float cumv[8];
      {
        float cum = 0.f;
#pragma unroll
        for (int jj = 0; jj < 8; ++jj) {
          const int j = part * 8 + jj;
          float x = ubias;
#pragma unroll
          for (int q = 0; q < 4; ++q) {
            const float4 l4 = *(const float4*)(lr_s + j * 16 + 4 * q);
            x += l4.x * upw[4 * q] + l4.y * upw[4 * q + 1] + l4.z * upw[4 * q + 2] + l4.w * upw[4 * q + 3];
          }
          cum += logsigf_(x) * (1.f / 16.f);
          cumv[jj] = cum;
        }
        tot_s[part * 64 + d] = cum;
      }
      __syncthreads();
      {
        float off = 0.f;
        for (int pp = 0; pp < part; ++pp) off += tot_s[pp * 64 + d];
#pragma unroll
        for (int jj = 0; jj < 8; ++jj) b_s[(part * 8 + jj) * 64 + d] = cumv[jj] + off;
        if (part == 7) blast_s[d] = cumv[7] + off;
      }
      __syncthreads();
      if (tid < 64) sumbl += blast_s[tid];
    } else {
      sumbl += 64.f * lg;
    }
    {
      const int row = tid >> 3, c8 = (tid & 7) * 8;
      const uint4 kv = kvr;
      float kf[8], bv[8], tmp[8];
      unpack8(kv, kf);
      if (!c.ret) {
        float bl8[8];
        {
          const float4 b0 = *(const float4*)(b_s + row * 64 + c8), b1 = *(const float4*)(b_s + row * 64 + c8 + 4);
          const float4 l0 = *(const float4*)(blast_s + c8), l1 = *(const float4*)(blast_s + c8 + 4);
          bv[0] = b0.x; bv[1] = b0.y; bv[2] = b0.z; bv[3] = b0.w; bv[4] = b1.x; bv[5] = b1.y; bv[6] = b1.z; bv[7] = b1.w;
          bl8[0] = l0.x; bl8[1] = l0.y; bl8[2] = l0.z; bl8[3] = l0.w; bl8[4] = l1.x; bl8[5] = l1.y; bl8[6] = l1.z; bl8[7] = l1.w;
        }
#pragma unroll
        for (int j = 0; j < 8; ++j) tmp[j] = kf[j] * fexp(-bv[j]);
        *(uint4*)(kin_s + row * 72 + c8) = pack8(tmp);
#pragma unroll
        for (int j = 0; j < 8; ++j) tmp[j] = kf[j] * fexp(bl8[j] - bv[j]);
        *(uint4*)(kst_s + row * 96 + c8) = pack8(tmp);
      } else {
        const float bb = (float)(row + 1) * lg;
        const float e1 = fexp(-bb), e2 = fexp(64.f * lg - bb);
#pragma unroll
        for (int j = 0; j < 8; ++j) { bv[j] = bb; tmp[j] = kf[j] * e1; }
        *(uint4*)(kin_s + row * 72 + c8) = pack8(tmp);
#pragma unroll
        for (int j = 0; j < 8; ++j) tmp[j] = kf[j] * e2;
        *(uint4*)(kst_s + row * 96 + c8) = pack8(tmp);
      }
      if (outc) {
        const uint4 qv = qvr;
        float qf[8];
        unpack8(qv, qf);
#pragma unroll
        for (int j = 0; j < 8; ++j) tmp[j] = qf[j] * fexp(bv[j]);
        *(uint4*)(qin_s + row * 72 + c8) = pack8(tmp);
      }
      const int v16 = (tid & 7) * 16;
      *(uint4*)(V_s + row * 160 + v16) = v0r;
      *(uint4*)(V_s + row * 160 + v16 + 8) = v1r;
      if (outc) {
#pragma unroll
        for (int g = 0; g < 4; ++g) {
          uint2 s2;
          s2.x = pack2(accS[4 * g], accS[4 * g + 1]);
          s2.y = pack2(accS[4 * g + 2], accS[4 * g + 3]);
          *(uint2*)(St_s + (nt * 32 + r) * 72 + mt * 32 + 8 * g + 4 * hh) = s2;
        }
      }
      if (cidx + 1 < cend) issue_kqv(cidx + 1);
    }
    __syncthreads();
    if (outc) {
      if (w < 4) {
        const int ms = w >> 1, ntq = w & 1;
        f32x16 a = zero16();
#pragma unroll
        for (int ks = 0; ks < 4; ++ks)
          a = mfma32(LDS8(kin_s + (ms * 32 + r) * 72 + ks * 16 + hh * 8), LDS8(qin_s + (ntq * 32 + r) * 72 + ks * 16 + hh * 8), a);
        const int t = ntq * 32 + r;
#pragma unroll
        for (int g = 0; g < 4; ++g) {
          const int s0 = ms * 32 + 8 * g + 4 * hh;
          float f[4];
#pragma unroll
          for (int j = 0; j < 4; ++j) f[j] = (s0 + j <= t) ? a[4 * g + j] : 0.f;
          uint2 s2;
          s2.x = pack2(f[0], f[1]); s2.y = pack2(f[2], f[3]);
          *(uint2*)(att_s + t * 72 + s0) = s2;
        }
      }
      __syncthreads();
    }
    f32x16 accO = zero16();
    const int mo = w >> 2;
    if (outc) {
#pragma unroll
      for (int ks = 0; ks < 4; ++ks)
        accO = mfma32(tr_frag(V_s, 160, ks, nt, trv), LDS8(att_s + (mo * 32 + r) * 72 + ks * 16 + hh * 8), accO);
#pragma unroll
      for (int ks = 0; ks < 4; ++ks)
        accO = mfma32(LDS8(St_s + (nt * 32 + r) * 72 + ks * 16 + hh * 8), LDS8(qin_s + (mo * 32 + r) * 72 + ks * 16 + hh * 8), accO);
    }
    if (!c.ret) {
#pragma unroll
      for (int g = 0; g < 4; ++g) {
        const float4 l4 = *(const float4*)(blast_s + mt * 32 + 8 * g + 4 * hh);
        accS[4 * g] *= fexp(l4.x); accS[4 * g + 1] *= fexp(l4.y); accS[4 * g + 2] *= fexp(l4.z); accS[4 * g + 3] *= fexp(l4.w);
      }
    } else {
      const float dk = fexp(64.f * lg);
#pragma unroll
      for (int i = 0; i < 16; ++i) accS[i] *= dk;
    }
#pragma unroll
    for (int ks = 0; ks < 4; ++ks)
      accS = mfma32(tr_frag(kst_s, 96, ks, mt, trk), tr_frag(V_s, 160, ks, nt, trv), accS);
    if (outc) {
#pragma unroll
      for (int g = 0; g < 4; ++g)
        *(float4*)(o_s + (mo * 32 + r) * 132 + nt * 32 + 8 * g + 4 * hh) = make_float4(accO[4 * g], accO[4 * g + 1], accO[4 * g + 2], accO[4 * g + 3]);
      __syncthreads();
      const int row = tid >> 3, v16 = (tid & 7) * 16;
      const int grow = rowof(seq, dir ? tb + 63 - row : tb + row);
      float vals[16];
#pragma unroll
      for (int q = 0; q < 4; ++q) {
        const float4 t4 = *(const float4*)(o_s + row * 132 + v16 + 4 * q);
        vals[4 * q] = t4.x; vals[4 * q + 1] = t4.y; vals[4 * q + 2] = t4.z; vals[4 * q + 3] = t4.w;
      }
      u16* yp = Y + (size_t)grow * 1024 + c.ycol + h * 128 + v16;
      if (!second) {
        *(uint4*)(yp) = pack8(vals);
        *(uint4*)(yp + 8) = pack8(vals + 8);
      } else {
        const uint4 o0 = o0r, o1 = o1r;
        float ob[16];
        unpack8(o0, ob);
        unpack8(o1, ob + 8);
        float ss = 0.f;
#pragma unroll
        for (int j = 0; j < 16; ++j) { vals[j] += ob[j]; ss += vals[j] * vals[j]; }
        ss += __shfl_xor(ss, 1);
        ss += __shfl_xor(ss, 2);
        ss += __shfl_xor(ss, 4);
        const float rstd = rsqrtf(ss * (1.f / 128.f) + 1e-6f);
        const uint4 g0 = g0r, g1 = g1r;
        float gf[16];
        unpack8(g0, gf);
        unpack8(g1, gf + 8);
#pragma unroll
        for (int j = 0; j < 16; ++j) vals[j] = (vals[j] * rstd * ngr[j]) * siluf_(gf[j]);
        *(uint4*)(yp) = pack8(vals);
        *(uint4*)(yp + 8) = pack8(vals + 8);
        if (cidx + 1 < cend) issue_epi(cidx + 1);
      }
    } else if (c.ret) {
      __syncthreads();
    }
  }
  if (write_state) {
#pragma unroll
    for (int i = 0; i < 16; ++i) GSp[(mt * 32 + 8 * (i >> 2) + 4 * hh + (i & 3)) * 128 + nt * 32 + r] = accS[i];
    if (tid < 64) GD[sidx * 64 + tid] = fexp(sumbl);
  }
  __syncthreads();
}

__device__ __forceinline__ void gla_passA(const P& p, const MixCfg& c, int b, int h, int seq, int tbase, int pf, int pb, char* lds) {
  const int tid = opq_tid(), lane = tid & 63, w = tid >> 6, r = lane & 31, hh = lane >> 5;
  float* lr_s = (float*)(lds);
  float* b_s = (float*)(lds + 8192);
  float* tot_s = (float*)(lds + 40960);
  float* blast_s = (float*)(lds + 45056);
  float* dacc_s = (float*)(lds + 45568);
  u16* kst_s = (u16*)(lds + 45824);
  u16* V_s = (u16*)(lds + 70400);
  const u16* Z = (const u16*)(p.ws + OFF_Z);
  float* GS = (float*)(p.ws + OFF_GS);
  float* GD = (float*)(p.ws + OFF_GD);
  const int trk = tr_lane_off(lane, 96), trv = tr_lane_off(lane, 160);
  const int dir2 = tid >> 8, d = tid & 63, part = (tid >> 6) & 3;
  float upw[16], ubias = 0.f;
  const float lgf = c.ret ? logsigf_(c.dec0[h]) : 0.f, lgb = c.ret ? logsigf_(c.dec1[h]) : 0.f;
  if (!c.ret) {
#pragma unroll
    for (int rr = 0; rr < 16; ++rr) upw[rr] = (dir2 ? c.up1 : c.up0)[rr * 256 + h * 64 + d];
    ubias = (dir2 ? c.ub1 : c.ub0)[h * 64 + d];
  } else {
#pragma unroll
    for (int rr = 0; rr < 16; ++rr) upw[rr] = 0.f;
  }
  const int mt = w >> 2, nt = w & 3;
  f32x16 accF = zero16(), accB = zero16();
  float sumf = 0.f, sumb = 0.f;
  uint4 lrv = make_uint4(0, 0, 0, 0), kvr, v0r, v1r;
  auto issue = [&](int cc) {
    const int tb = tbase + 64 * cc;
    if (!c.ret && tid < 256) lrv = *(const uint4*)(Z + (size_t)rowof(seq, tb + (tid >> 2)) * ZW + c.lrcol + (tid & 3) * 8);
    const u16* zr = Z + (size_t)rowof(seq, tb + (tid >> 3)) * ZW;
    kvr = *(const uint4*)(zr + c.kcol + h * 64 + (tid & 7) * 8);
    v0r = *(const uint4*)(zr + c.vcol + h * 128 + (tid & 7) * 16);
    v1r = *(const uint4*)(zr + c.vcol + h * 128 + (tid & 7) * 16 + 8);
  };
  issue(0);
  if (tid < 64) dacc_s[tid] = 0.f;
#pragma unroll
  for (int cidx = 0; cidx < 4; ++cidx) {
    if (!c.ret) {
      if (tid < 256) {
        float f[8];
        unpack8(lrv, f);
#pragma unroll
        for (int j = 0; j < 8; ++j) lr_s[(tid >> 2) * 32 + (tid & 3) * 8 + j] = f[j];
      }
      __syncthreads();
      float cumv[16];
      {
        float cum = 0.f;
#pragma unroll
        for (int jj = 0; jj < 16; ++jj) {
          const int j = part * 16 + jj;
          float x = ubias;
#pragma unroll
          for (int q = 0; q < 4; ++q) {
            const float4 l4 = *(const float4*)(lr_s + j * 32 + dir2 * 16 + 4 * q);
            x += l4.x * upw[4 * q] + l4.y * upw[4 * q + 1] + l4.z * upw[4 * q + 2] + l4.w * upw[4 * q + 3];
          }
          cum += logsigf_(x) * (1.f / 16.f);
          cumv[jj] = cum;
        }
        tot_s[(dir2 * 4 + part) * 64 + d] = cum;
      }
      __syncthreads();
      {
        float off = 0.f;
        for (int pp = 0; pp < part; ++pp) off += tot_s[(dir2 * 4 + pp) * 64 + d];
#pragma unroll
        for (int jj = 0; jj < 16; ++jj) b_s[(dir2 * 64 + part * 16 + jj) * 64 + d] = cumv[jj] + off;
        if (part == 3) blast_s[dir2 * 64 + d] = cumv[15] + off;
      }
      __syncthreads();
    }
    {
      const int row = tid >> 3, c8 = (tid & 7) * 8;
      float kf[8], tf[8], tb8[8];
      unpack8(kvr, kf);
      if (!c.ret) {
        float bf8[8], bl8[8], ex8[8], da8[8];
        {
          const float4 a0 = *(const float4*)(b_s + row * 64 + c8), a1 = *(const float4*)(b_s + row * 64 + c8 + 4);
          const float4 l0 = *(const float4*)(blast_s + c8), l1 = *(const float4*)(blast_s + c8 + 4);
          const float4 d0 = *(const float4*)(dacc_s + c8), d1 = *(const float4*)(dacc_s + c8 + 4);
          float4 e0 = make_float4(0.f, 0.f, 0.f, 0.f), e1 = e0;
          if (row > 0) { e0 = *(const float4*)(b_s + (64 + row - 1) * 64 + c8); e1 = *(const float4*)(b_s + (64 + row - 1) * 64 + c8 + 4); }
          bf8[0] = a0.x; bf8[1] = a0.y; bf8[2] = a0.z; bf8[3] = a0.w; bf8[4] = a1.x; bf8[5] = a1.y; bf8[6] = a1.z; bf8[7] = a1.w;
          bl8[0] = l0.x; bl8[1] = l0.y; bl8[2] = l0.z; bl8[3] = l0.w; bl8[4] = l1.x; bl8[5] = l1.y; bl8[6] = l1.z; bl8[7] = l1.w;
          da8[0] = d0.x; da8[1] = d0.y; da8[2] = d0.z; da8[3] = d0.w; da8[4] = d1.x; da8[5] = d1.y; da8[6] = d1.z; da8[7] = d1.w;
          ex8[0] = e0.x; ex8[1] = e0.y; ex8[2] = e0.z; ex8[3] = e0.w; ex8[4] = e1.x; ex8[5] = e1.y; ex8[6] = e1.z; ex8[7] = e1.w;
        }
#pragma unroll
        for (int j = 0; j < 8; ++j) {
          tf[j] = kf[j] * fexp(bl8[j] - bf8[j]);
          tb8[j] = kf[j] * fexp(ex8[j] + da8[j]);
        }
      } else {
        const float ef = fexp((float)(63 - row) * lgf), eb = fexp((float)(row + 64 * cidx) * lgb);
#pragma unroll
        for (int j = 0; j < 8; ++j) { tf[j] = kf[j] * ef; tb8[j] = kf[j] * eb; }
      }
      *(uint4*)(kst_s + row * 96 + c8) = pack8(tf);
      *(uint4*)(kst_s + (64 + row) * 96 + c8) = pack8(tb8);
      const int v16 = (tid & 7) * 16;
      *(uint4*)(V_s + row * 160 + v16) = v0r;
      *(uint4*)(V_s + row * 160 + v16 + 8) = v1r;
      if (cidx + 1 < 4) issue(cidx + 1);
    }
    __syncthreads();
    if (!c.ret) {
#pragma unroll
      for (int g = 0; g < 4; ++g) {
        const float4 l4 = *(const float4*)(blast_s + mt * 32 + 8 * g + 4 * hh);
        accF[4 * g] *= fexp(l4.x); accF[4 * g + 1] *= fexp(l4.y); accF[4 * g + 2] *= fexp(l4.z); accF[4 * g + 3] *= fexp(l4.w);
      }
    } else {
      const float dk = fexp(64.f * lgf);
#pragma unroll
      for (int i = 0; i < 16; ++i) accF[i] *= dk;
    }
#pragma unroll
    for (int ks = 0; ks < 4; ++ks) {
      const bf16x8 vb = tr_frag(V_s, 160, ks, nt, trv);
      accF = mfma32(tr_frag(kst_s, 96, ks, mt, trk), vb, accF);
      accB = mfma32(tr_frag(kst_s + 64 * 96, 96, ks, mt, trk), vb, accB);
    }
    if (!c.ret) {
      if (tid < 64) { sumf += blast_s[tid]; sumb += blast_s[64 + tid]; }
    } else {
      sumf += 64.f * lgf; sumb += 64.f * lgb;
    }
    __syncthreads();
    if (!c.ret && tid < 64) dacc_s[tid] = sumb;
  }
  {
    float* GF = GS + (((size_t)(0 * 2 + b) * 4 + h) * 65 + pf) * 8192;
    float* GB = GS + (((size_t)(1 * 2 + b) * 4 + h) * 65 + pb) * 8192;
#pragma unroll
    for (int i = 0; i < 16; ++i) {
      const int o = (mt * 32 + 8 * (i >> 2) + 4 * hh + (i & 3)) * 128 + nt * 32 + r;
      GF[o] = accF[i];
      GB[o] = accB[i];
    }
    if (tid < 64) {
      GD[(((size_t)(0 * 2 + b) * 4 + h) * 65 + pf) * 64 + tid] = fexp(sumf);
      GD[(((size_t)(1 * 2 + b) * 4 + h) * 65 + pb) * 64 + tid] = fexp(sumb);
    }
  }
  __syncthreads();
}

__device__ __forceinline__ void lru_coeff_item(const P& p, int jl, int b, int sidx, int nblk, char* lds) {
  const int tid0 = opq_tid();
  u16* xr_s = (u16*)(lds);
  u16* xcb = (u16*)(lds + 17408);
  float* xcf = (float*)(lds + 34816);
  u16* la_s = (u16*)(lds + 67584);
  u16* u_s = (u16*)(lds + 102400);
  const u16* Z = (const u16*)(p.ws + OFF_Z);
  u16* LA = (u16*)(p.ws + OFF_LA);
  u16* LU = (u16*)(p.ws + OFF_LU);
  float* LSA = (float*)(p.ws + OFF_LSA);
  float* LSU = (float*)(p.ws + OFF_LSU);
  int seq, tbase, Ls;
  if (sidx < 2) { seq = 2 + b; tbase = sidx * 128; Ls = LC; }
  else { seq = b; tbase = (sidx - 2) * 128; Ls = L; }
  const int dir0 = tid0 >> 8;
  const u16* WL = (const u16*)(p.ws + OFF_WLRU);
  const int gchl = jl * 512 + nblk * 128 + ((tid0 >> 6) & 3) * 32 + (tid0 & 31);
  const float ba = (dir0 ? p.in[21] : p.in[16])[gchl];
  const float bx = (dir0 ? p.in[23] : p.in[18])[gchl];
  const float c8l = 8.f * logsigf_((dir0 ? p.in[24] : p.in[19])[gchl]);
  float LAacc = 0.f, Uacc = 0.f;
  float w0[4], w1[4], cb0, cb1;
  {
    const int ch2 = (tid0 & 63) * 2;
    const float* cw = p.in[13] + jl * 4 * 512 + nblk * 128 + ch2;
    const float* cbp = p.in[14] + jl * 512 + nblk * 128 + ch2;
#pragma unroll
    for (int j = 0; j < 4; ++j) { w0[j] = cw[j * 512]; w1[j] = cw[j * 512 + 1]; }
    cb0 = cbp[0]; cb1 = cbp[1];
  }
  uint4 xv[3];
  auto issue_xr = [&](int stt) {
#pragma unroll
    for (int q = 0; q < 3; ++q) {
      const int cc = tid0 + 512 * q;
      const int jj = cc >> 4, c8 = (cc & 15) * 8;
      const int t = tbase + 64 * stt - 2 + jj;
      xv[q] = make_uint4(0, 0, 0, 0);
      if (cc < 67 * 16 && t >= 0 && t < Ls) xv[q] = *(const uint4*)(Z + (size_t)rowof(seq, t) * ZW + 1568 + nblk * 128 + c8);
    }
  };
  issue_xr(0);
#pragma unroll 1
  for (int st = 0; st < 2; ++st) {
    const int tid = opq_tid(), lane = tid & 63, w = tid >> 6, r = lane & 31, hh = lane >> 5;
    const int dir = w >> 2, nq = w & 3;
    const int t0 = tbase + 64 * st;
#pragma unroll
    for (int q = 0; q < 3; ++q) {
      const int cc = tid + 512 * q;
      if (cc < 67 * 16) *(uint4*)(xr_s + (cc >> 4) * 128 + (cc & 15) * 8) = xv[q];
    }
    if (st == 0) issue_xr(1);
    bf16x8 bq0[8];
    {
      const u16* wb = WL + (size_t)((jl * 4 + dir * 2 + 0) * 4 + nblk) * 16384 + (nq * 8 * 64 + lane) * 8;
#pragma unroll
      for (int ks = 0; ks < 8; ++ks) bq0[ks] = *(const bf16x8*)(wb + ks * 512);
    }
    __syncthreads();
    {
      const int ch2 = (tid & 63) * 2, r0 = (tid >> 6) * 8;
      float x0[11], x1[11];
#pragma unroll
      for (int j = 0; j < 11; ++j) {
        const unsigned u = *(const unsigned*)(xr_s + (r0 + j) * 128 + ch2);
        x0[j] = lo2f(u); x1[j] = hi2f(u);
      }
#pragma unroll
      for (int rr = 0; rr < 8; ++rr) {
        float a0 = cb0, a1 = cb1;
#pragma unroll
        for (int j = 0; j < 4; ++j) { a0 += w0[j] * x0[rr + j]; a1 += w1[j] * x1[rr + j]; }
        *(float2*)(xcf + (r0 + rr) * 128 + ch2) = make_float2(a0, a1);
        *(unsigned*)(xcb + (r0 + rr) * 136 + ch2) = pack2(a0, a1);
      }
    }
    __syncthreads();
    float lav[2][16];
#pragma unroll
    for (int mat = 0; mat < 2; ++mat) {
      const u16* wb = WL + (size_t)((jl * 4 + dir * 2 + mat) * 4 + nblk) * 16384 + (nq * 8 * 64 + lane) * 8;
      f32x16 acc0 = zero16(), acc1 = zero16();
#pragma unroll
      for (int ks = 0; ks < 8; ++ks) {
        const bf16x8 bq = (mat == 0) ? bq0[ks] : *(const bf16x8*)(wb + ks * 512);
        acc0 = mfma32(LDS8(xcb + r * 136 + ks * 16 + hh * 8), bq, acc0);
        acc1 = mfma32(LDS8(xcb + (32 + r) * 136 + ks * 16 + hh * 8), bq, acc1);
      }
      const int ch = nq * 32 + r;
      if (mat == 0) {
#pragma unroll
        for (int i = 0; i < 16; ++i) { lav[0][i] = c8l * sigmoidf_(acc0[i] + ba); lav[1][i] = c8l * sigmoidf_(acc1[i] + ba); }
      } else {
#pragma unroll
        for (int mi = 0; mi < 2; ++mi)
#pragma unroll
          for (int g4 = 0; g4 < 4; ++g4) {
            float lq[4], uq[4];
#pragma unroll
            for (int j = 0; j < 4; ++j) {
              const int i = 4 * g4 + j;
              const int row = mi * 32 + 8 * g4 + 4 * hh + j;
              const float ig = sigmoidf_((mi ? acc1[i] : acc0[i]) + bx);
              const float la = lav[mi][i];
              lq[j] = la;
              uq[j] = __builtin_amdgcn_sqrtf(fmaxf(1.f - fexp(2.f * la), 0.f)) * (ig * xcf[row * 128 + ch]);
            }
            const int o = (dir * 128 + ch) * 68 + mi * 32 + 8 * g4 + 4 * hh;
            uint2 l2, u2;
            l2.x = pack2(lq[0], lq[1]); l2.y = pack2(lq[2], lq[3]);
            u2.x = pack2(uq[0], uq[1]); u2.y = pack2(uq[2], uq[3]);
            *(uint2*)(la_s + o) = l2;
            *(uint2*)(u_s + o) = u2;
          }
      }
    }
    __syncthreads();
    {
      const size_t tile = (size_t)(rowof(seq, t0) >> 6);
#pragma unroll
      for (int i = 0; i < 8; ++i) {
        const int cc = tid + 512 * i;
        const int arr = cc >> 10, rem = cc & 1023, chh = rem >> 3, tk = rem & 7;
        const int dirr = arr & 1, isu = arr >> 1;
        const u16* src = (isu ? u_s : la_s) + (dirr * 128 + chh) * 68 + tk * 8;
        u16* dst = (isu ? LU : LA) + (((size_t)dirr * 520 + tile) * 512 + nblk * 128 + chh) * 64 + tk * 8;
        const uint2 lo = *(const uint2*)(src), hi = *(const uint2*)(src + 4);
        *(uint4*)dst = make_uint4(lo.x, lo.y, hi.x, hi.y);
      }
    }
    if (tid < 256) {
      const int dirr = tid >> 7, ch = tid & 127;
      const u16* lp = la_s + (dirr * 128 + ch) * 68;
      const u16* up = u_s + (dirr * 128 + ch) * 68;
      float hloc = 0.f, las = 0.f;
      if (dirr == 0) {
#pragma unroll
        for (int q = 0; q < 16; ++q) {
          const uint2 l2 = *(const uint2*)(lp + q * 4), u2 = *(const uint2*)(up + q * 4);
          const float lf[4] = {lo2f(l2.x), hi2f(l2.x), lo2f(l2.y), hi2f(l2.y)};
          const float uf[4] = {lo2f(u2.x), hi2f(u2.x), lo2f(u2.y), hi2f(u2.y)};
#pragma unroll
          for (int j = 0; j < 4; ++j) { hloc = fexp(lf[j]) * hloc + uf[j]; las += lf[j]; }
        }
      } else {
#pragma unroll
        for (int q = 15; q >= 0; --q) {
          const uint2 l2 = *(const uint2*)(lp + q * 4), u2 = *(const uint2*)(up + q * 4);
          const float lf[4] = {lo2f(l2.x), hi2f(l2.x), lo2f(l2.y), hi2f(l2.y)};
          const float uf[4] = {lo2f(u2.x), hi2f(u2.x), lo2f(u2.y), hi2f(u2.y)};
#pragma unroll
          for (int j = 3; j >= 0; --j) { hloc = fexp(lf[j]) * hloc + uf[j]; las += lf[j]; }
        }
      }
      if (dirr == 0) Uacc = fexp(las) * Uacc + hloc;
      else Uacc = Uacc + fexp(LAacc) * hloc;
      LAacc += las;
    }
    __syncthreads();
  }
  if (tid0 < 256) {
    const int dirr = tid0 >> 7, ch = tid0 & 127;
    const int pidx = dirr == 0 ? sidx : (sidx < 2 ? 1 - sidx : 131 - sidx);
    const size_t idx = ((size_t)(dirr * 2 + b) * 130 + pidx) * 512 + nblk * 128 + ch;
    LSA[idx] = LAacc;
    LSU[idx] = Uacc;
  }
}

__device__ __forceinline__ void lru_final_item(const P& p, int b, int sidx) {
  const int ch = opq_tid();
  const u16* Z = (const u16*)(p.ws + OFF_Z);
  u16* Y = (u16*)(p.ws + OFF_HY);
  const u16* LA = (const u16*)(p.ws + OFF_LA);
  const u16* LU = (const u16*)(p.ws + OFF_LU);
  const float* LSU = (const float*)(p.ws + OFF_LSU);
  int seq, tbase;
  if (sidx < 2) { seq = 2 + b; tbase = sidx * 128; }
  else { seq = b; tbase = (sidx - 2) * 128; }
  const int grow0 = rowof(seq, tbase);
  const size_t tile0 = (size_t)(grow0 >> 6);
  const int p_fw = sidx, p_bw = sidx < 2 ? 1 - sidx : 131 - sidx;
  unsigned hbp[64];
  {
    float h = LSU[((size_t)(2 + b) * 130 + p_bw) * 512 + ch];
#pragma unroll
    for (int tl = 1; tl >= 0; --tl) {
      const uint4* lp = (const uint4*)(LA + (((size_t)520 + tile0 + tl) * 512 + ch) * 64);
      const uint4* up = (const uint4*)(LU + (((size_t)520 + tile0 + tl) * 512 + ch) * 64);
      uint4 lv[8], uv[8];
#pragma unroll
      for (int q = 0; q < 8; ++q) { lv[q] = lp[q]; uv[q] = up[q]; }
#pragma unroll
      for (int q = 7; q >= 0; --q) {
        float lf[8], uf[8];
        unpack8(lv[q], lf);
        unpack8(uv[q], uf);
#pragma unroll
        for (int j = 7; j >= 0; j -= 2) {
          h = fexp(lf[j]) * h + uf[j];
          const float h1 = h;
          h = fexp(lf[j - 1]) * h + uf[j - 1];
          hbp[(tl * 64 + q * 8 + j) >> 1] = pack2(h, h1);
        }
      }
    }
  }
  {
    float h = LSU[((size_t)(b) * 130 + p_fw) * 512 + ch];
    const u16* gp = Z + (size_t)grow0 * ZW + 2080 + ch;
    u16* yp = Y + (size_t)grow0 * 1024 + 512 + ch;
#pragma unroll
    for (int tl = 0; tl < 2; ++tl) {
      const uint4* lp = (const uint4*)(LA + ((tile0 + tl) * 512 + ch) * 64);
      const uint4* up = (const uint4*)(LU + ((tile0 + tl) * 512 + ch) * 64);
      uint4 lv[8], uv[8];
#pragma unroll
      for (int q = 0; q < 8; ++q) { lv[q] = lp[q]; uv[q] = up[q]; }
#pragma unroll
      for (int q = 0; q < 8; ++q) {
        float lf[8], uf[8];
        unpack8(lv[q], lf);
        unpack8(uv[q], uf);
        u16 g[8];
#pragma unroll
        for (int j = 0; j < 8; ++j) g[j] = gp[(size_t)(tl * 64 + q * 8 + j) * ZW];
#pragma unroll
        for (int j = 0; j < 8; ++j) {
          const int t = tl * 64 + q * 8 + j;
          h = fexp(lf[j]) * h + uf[j];
          const unsigned hp = hbp[t >> 1];
          const float hb = (t & 1) ? hi2f(hp) : lo2f(hp);
          yp[(size_t)t * 1024] = f2bf((h + hb) * siluf_(bf2f(g[j])));
        }
      }
    }
  }
}

__device__ __forceinline__ void attn_item(const P& p, int jl, bool isctx, int b, int qb, int kvh, char* lds) {
  const int tid = opq_tid(), lane = tid & 63, w = tid >> 6, r = lane & 31, hh = lane >> 5;
  u16* K_s = (u16*)(lds);
  u16* V_s = (u16*)(lds + 9216);
  u16* Pw = (u16*)(lds + 21504) + w * 64 * 72;
  const int trv = tr_lane_off(lane, 96);
  const u16* Z = (const u16*)(p.ws + OFF_Z);
  u16* Y = (u16*)(p.ws + OFF_HY);
  const int g = w >> 1, half = w & 1, qh = kvh * 4 + g;
  const int qseq = isctx ? 2 + b : b;
  const int t0 = qb * 128;
  bf16x8 qf[2][4];
#pragma unroll
  for (int n = 0; n < 2; ++n) {
    const int qrow = rowof(qseq, t0 + half * 64 + n * 32 + r);
#pragma unroll
    for (int ks = 0; ks < 4; ++ks) qf[n][ks] = *(const bf16x8*)(Z + (size_t)qrow * ZW + qh * 64 + ks * 16 + hh * 8);
  }
  const float sink = p.in[27][jl * 8 + qh];
  float m[2] = {sink, sink};
  float l[2] = {hh == 0 ? 1.f : 0.f, hh == 0 ? 1.f : 0.f};
  f32x16 accO[2][2];
#pragma unroll
  for (int a = 0; a < 2; ++a)
#pragma unroll
    for (int n = 0; n < 2; ++n) accO[a][n] = zero16();
  int ilo = 0, ihi = 0;
  if (!isctx) { ilo = t0 >= 128 ? 0 : 2; ihi = (t0 + 256 <= L) ? 6 : 4; }
  const int nlat = ihi - ilo, ntiles = nlat + 4;
  const int tqlo = t0 + half * 64;
  uint4 kvr, vvr;
  auto issue_kv = [&](int j) {
    const int key = tid >> 3, c8 = (tid & 7) * 8;
    const int row = (j < nlat) ? rowof(b, t0 - 128 + 64 * (ilo + j) + key) : rowof(2 + b, (j - nlat) * 64 + key);
    const u16* zr = Z + (size_t)row * ZW;
    kvr = *(const uint4*)(zr + 512 + kvh * 64 + c8);
    vvr = *(const uint4*)(zr + 640 + kvh * 64 + c8);
  };
  issue_kv(0);
  for (int ti = 0; ti < ntiles; ++ti) {
    const bool lat = ti < nlat;
    const int kt = lat ? t0 - 128 + 64 * (ilo + ti) : (ti - nlat) * 64;
    const bool skip = lat && (kt - (tqlo + 63) > 128 || kt + 63 - tqlo < -128);
    const bool masked = lat && (kt + 63 - tqlo > 128 || kt - (tqlo + 63) < -128);
    {
      const int key = tid >> 3, c8 = (tid & 7) * 8;
      *(uint4*)(K_s + key * 72 + c8) = kvr;
      *(uint4*)(V_s + key * 96 + c8) = vvr;
    }
    if (ti + 1 < ntiles) issue_kv(ti + 1);
    __syncthreads();
    if (!skip) {
    f32x16 s[2][2];
#pragma unroll
    for (int a = 0; a < 2; ++a)
#pragma unroll
      for (int n = 0; n < 2; ++n) s[a][n] = zero16();
#pragma unroll
    for (int ks = 0; ks < 4; ++ks) {
      const bf16x8 a0 = LDS8(K_s + r * 72 + ks * 16 + hh * 8);
      const bf16x8 a1 = LDS8(K_s + (32 + r) * 72 + ks * 16 + hh * 8);
      s[0][0] = mfma32(a0, qf[0][ks], s[0][0]);
      s[0][1] = mfma32(a0, qf[1][ks], s[0][1]);
      s[1][0] = mfma32(a1, qf[0][ks], s[1][0]);
      s[1][1] = mfma32(a1, qf[1][ks], s[1][1]);
    }
    if (masked) {
#pragma unroll
      for (int mk = 0; mk < 2; ++mk)
#pragma unroll
        for (int n = 0; n < 2; ++n)
#pragma unroll
          for (int i = 0; i < 16; ++i) {
            const int kp = kt + mk * 32 + 8 * (i >> 2) + 4 * hh + (i & 3);
            const int dl = kp - (tqlo + n * 32 + r);
            if (dl > 128 || dl < -128) s[mk][n][i] = -1e30f;
          }
    }
#pragma unroll
    for (int n = 0; n < 2; ++n) {
      float mx = -1e30f;
#pragma unroll
      for (int mk = 0; mk < 2; ++mk)
#pragma unroll
        for (int i = 0; i < 16; ++i) mx = fmaxf(mx, s[mk][n][i]);
      mx = fmaxf(mx, __shfl_xor(mx, 32));
      const float mn = fmaxf(m[n], mx);
      const float alpha = fexp(m[n] - mn);
      m[n] = mn;
      float ls = 0.f;
#pragma unroll
      for (int mk = 0; mk < 2; ++mk)
#pragma unroll
        for (int i = 0; i < 16; ++i) {
          const float pv = fexp(s[mk][n][i] - mn);
          s[mk][n][i] = pv;
          ls += pv;
        }
      l[n] = l[n] * alpha + ls;
#pragma unroll
      for (int mv = 0; mv < 2; ++mv)
#pragma unroll
        for (int i = 0; i < 16; ++i) accO[mv][n][i] *= alpha;
#pragma unroll
      for (int mk = 0; mk < 2; ++mk)
#pragma unroll
        for (int g4 = 0; g4 < 4; ++g4) {
          uint2 s2;
          s2.x = pack2(s[mk][n][4 * g4], s[mk][n][4 * g4 + 1]);
          s2.y = pack2(s[mk][n][4 * g4 + 2], s[mk][n][4 * g4 + 3]);
          *(uint2*)(Pw + (n * 32 + r) * 72 + mk * 32 + 8 * g4 + 4 * hh) = s2;
        }
    }
    }
    __syncthreads();
    if (!skip) {
#pragma unroll
    for (int ks = 0; ks < 4; ++ks) {
      const bf16x8 b0 = LDS8(Pw + r * 72 + ks * 16 + hh * 8);
      const bf16x8 b1 = LDS8(Pw + (32 + r) * 72 + ks * 16 + hh * 8);
      const bf16x8 a0 = tr_frag(V_s, 96, ks, 0, trv);
      const bf16x8 a1 = tr_frag(V_s, 96, ks, 1, trv);
      accO[0][0] = mfma32(a0, b0, accO[0][0]);
      accO[0][1] = mfma32(a0, b1, accO[0][1]);
      accO[1][0] = mfma32(a1, b0, accO[1][0]);
      accO[1][1] = mfma32(a1, b1, accO[1][1]);
    }
    }
    __syncthreads();
  }
#pragma unroll
  for (int n = 0; n < 2; ++n) {
    const float lt = l[n] + __shfl_xor(l[n], 32);
    const float inv = __builtin_amdgcn_rcpf(lt);
    const int qrow = rowof(qseq, t0 + half * 64 + n * 32 + r);
    const u16* gp = Z + (size_t)qrow * ZW + 768 + qh * 64;
    u16* yp = Y + (size_t)qrow * 1024 + qh * 64;
#pragma unroll
    for (int mv = 0; mv < 2; ++mv)
#pragma unroll
      for (int g4 = 0; g4 < 4; ++g4) {
        const int v0 = mv * 32 + 8 * g4 + 4 * hh;
        const uint2 gv = *(const uint2*)(gp + v0);
        const float o0 = accO[mv][n][4 * g4] * inv * siluf_(lo2f(gv.x));
        const float o1 = accO[mv][n][4 * g4 + 1] * inv * siluf_(hi2f(gv.x));
        const float o2 = accO[mv][n][4 * g4 + 2] * inv * siluf_(lo2f(gv.y));
        const float o3 = accO[mv][n][4 * g4 + 3] * inv * siluf_(hi2f(gv.y));
        uint2 ov;
        ov.x = pack2(o0, o1); ov.y = pack2(o2, o3);
        *(uint2*)(yp + v0) = ov;
      }
  }
}

__device__ __forceinline__ void make_cfg(const P& p, int l, MixCfg& c) {
  const int jl = l >> 1;
  if ((l & 1) == 0) {
    c.qcol = 0; c.kcol = 256; c.vcol = 512; c.gcol = 1024; c.ycol = 0; c.lrcol = 1536; c.ret = 0; c.pad = 0;
    c.up0 = p.in[8] + jl * 16 * 256; c.up1 = p.in[10] + jl * 16 * 256;
    c.ub0 = p.in[9] + jl * 256; c.ub1 = p.in[11] + jl * 256;
    c.dec0 = p.in[28]; c.dec1 = p.in[29];
    c.ng = p.in[12] + jl * 128;
  } else {
    c.qcol = 1280; c.kcol = 1536; c.vcol = 1792; c.gcol = 2304; c.ycol = 512; c.lrcol = 0; c.ret = 1; c.pad = 0;
    c.up0 = p.in[8]; c.up1 = p.in[10];
    c.ub0 = p.in[9]; c.ub1 = p.in[11];
    c.dec0 = p.in[28] + jl * 4; c.dec1 = p.in[29] + jl * 4;
    c.ng = p.in[30] + jl * 128;
  }
}

__device__ __forceinline__ void phase_mix1(const P& p, int l, char* lds) {
  MixCfg c;
  make_cfg(p, l, c);
  const int jl = l >> 1;
  const bool odd = (l & 1) != 0;
  const int G = gridDim.x;
  if (odd) {
    for (int rp = 0; rp < ((PROBE_REP & 0x100) ? 2 : 1); ++rp)
    for (int it = blockIdx.x; it < 512; it += G) attn_item(p, jl, false, it >> 8, (it >> 1) & 127, it & 1, lds);
  } else {
    const int vb = (blockIdx.x + G - 16) % G;
    for (int rp = 0; rp < ((PROBE_REP & 0x200) ? 2 : 1); ++rp)
    for (int it = vb; it < 1040; it += G) {
      int bb, sidx, nblk;
      if (it < 1024) { nblk = it & 3; sidx = 2 + ((it >> 2) & 127); bb = it >> 9; }
      else { const int j = it - 1024; nblk = j & 3; sidx = (j >> 2) & 1; bb = j >> 3; }
      lru_coeff_item(p, jl, bb, sidx, nblk, lds);
    }
  }
  {
    const int vb = (blockIdx.x + G - 40) % G;
    for (int rp = 0; rp < ((PROBE_REP & 0x400) ? 2 : 1); ++rp)
    for (int it = vb; it < 552; it += G) {
      if (it < 512) {
        const int seg = it & 63, rest = it >> 6;
        gla_passA(p, c, rest >> 2, rest & 3, rest >> 2, seg * 256, seg + 1, 64 - seg, lds);
      } else if (it < 520) {
        const int j = it - 512;
        gla_passA(p, c, j >> 2, j & 3, 2 + (j >> 2), 0, 0, 0, lds);
      } else {
        const int j = it - 520, k = j & 3, bh = j >> 2;
        gla_dir_pass(p, c, bh >> 2, bh & 3, 1, 0, lds, true, false, k + 1, k, false);
      }
    }
  }
}

__device__ __forceinline__ void phase_scan(const P& p, int l, char* lds) {
  float* GS = (float*)(p.ws + OFF_GS);
  const float* GD = (const float*)(p.ws + OFF_GD);
  const int tid = opq_tid();
  for (int gidx = blockIdx.x * 512 + tid; gidx < 16 * 8192; gidx += gridDim.x * 512) {
    const int combo = gidx >> 13, e = gidx & 8191;
    float* gs = GS + (size_t)combo * 65 * 8192 + e;
    const float* gd = GD + (size_t)combo * 65 * 64 + (e >> 7);
    float S = 0.f;
#pragma unroll 1
    for (int q0 = 0; q0 < 65; q0 += 13) {
      float ev[13], dd[13];
#pragma unroll
      for (int q = 0; q < 13; ++q) { ev[q] = gs[(size_t)(q0 + q) * 8192]; dd[q] = gd[(q0 + q) * 64]; }
#pragma unroll
      for (int q = 0; q < 13; ++q) {
        gs[(size_t)(q0 + q) * 8192] = S;
        S = dd[q] * S + ev[q];
      }
    }
  }
  if ((l & 1) == 0) {
    const float* LSA = (const float*)(p.ws + OFF_LSA);
    float* LSU = (float*)(p.ws + OFF_LSU);
    for (int gidx = blockIdx.x * 512 + tid; gidx < 2048; gidx += gridDim.x * 512) {
      const int combo = gidx >> 9, ch = gidx & 511;
      const float* pa = LSA + (size_t)combo * 130 * 512 + ch;
      float* pu = LSU + (size_t)combo * 130 * 512 + ch;
      float hin = 0.f;
#pragma unroll 1
      for (int q0 = 0; q0 < 130; q0 += 13) {
        float la[13], u[13];
#pragma unroll
        for (int q = 0; q < 13; ++q) { la[q] = pa[(q0 + q) * 512]; u[q] = pu[(q0 + q) * 512]; }
#pragma unroll
        for (int q = 0; q < 13; ++q) {
          pu[(q0 + q) * 512] = hin;
          hin = fexp(la[q]) * hin + u[q];
        }
      }
    }
  }
  {
    MixCfg c;
    make_cfg(p, l, c);
    const int G = gridDim.x;
    const int vb = (blockIdx.x + G - 64) % G;
    for (int it = vb; it < 32; it += G) {
      const int k = it & 3, bh = it >> 2;
      gla_dir_pass(p, c, bh >> 2, bh & 3, 0, 0, lds, true, true, k + 1, k, false);
    }
    if (l & 1) {
      const int vb2 = (blockIdx.x + G - 128) % G;
      for (int it = vb2; it < 8; it += G) attn_item(p, l >> 1, true, it >> 2, (it >> 1) & 1, it & 1, lds);
    }
  }
}

__device__ __forceinline__ void phase_mix2(const P& p, int l, char* lds) {
  MixCfg c;
  make_cfg(p, l, c);
  const bool odd = (l & 1) != 0;
  const int G = gridDim.x;
  for (int rp = 0; rp < ((PROBE_REP & 0x800) ? 2 : 1); ++rp)
  for (int it = blockIdx.x; it < 512; it += G) {
    const int sidx = 1 + (it & 63), rest = it >> 6;
    const int h = rest & 3, b = rest >> 2;
    for (int dd = 1; dd >= 0; --dd) gla_dir_pass(p, c, b, h, dd, dd ? 65 - sidx : sidx, lds, true, dd == 0, 4, 0, false);
  }
  if (!odd) {
    const int vb = (blockIdx.x + G - 64) % G;
    for (int it = vb; it < 260; it += G) {
      if (it < 256) lru_final_item(p, it >> 7, 2 + (it & 127));
      else lru_final_item(p, (it - 256) >> 1, (it - 256) & 1);
    }
  }
}

__device__ __forceinline__ void grid_barrier(unsigned* ctr, unsigned target) {
  asm volatile("s_waitcnt vmcnt(0)" ::: "memory");
  __syncthreads();
  if (threadIdx.x == 0) {
    __builtin_amdgcn_fence(__ATOMIC_RELEASE, "agent");
    asm volatile("s_waitcnt vmcnt(0)" ::: "memory");
    __hip_atomic_fetch_add(ctr, 1u, __ATOMIC_RELAXED, __HIP_MEMORY_SCOPE_AGENT);
    unsigned sp = 0;
    while (__hip_atomic_load(ctr, __ATOMIC_RELAXED, __HIP_MEMORY_SCOPE_AGENT) < target) {
      __builtin_amdgcn_s_sleep(1);
      if (++sp > (1u << 24)) break;
    }
    __builtin_amdgcn_fence(__ATOMIC_ACQUIRE, "agent");
    asm volatile("s_waitcnt vmcnt(0)" ::: "memory");
  }
  __syncthreads();
}

__global__ void __launch_bounds__(512) fwd_megakernel(P p) {
  extern __shared__ __attribute__((aligned(16))) char lds[];
  const int ph_lo = p.ph_lo, ph_hi = p.ph_hi;
  unsigned nbar = 0;
  unsigned* bar_ctr = (unsigned*)(p.ws + OFF_BAR);
  for (int i = 0; i < PROBE_SYNC; ++i) { ++nbar; grid_barrier(bar_ctr, nbar * gridDim.x); }
  for (int ph = ph_lo; ph < ph_hi; ++ph) {
    int reps = 1;
    if (PROBE_REP) {
      const int l = (ph - 1) / 6, s = (ph - 1) % 6;
      if (ph == 0) { if (PROBE_REP & 64) reps = 2; }
      else if (ph < NPH - 1 && s != 3 && (s != 5 || l == 0) && ((PROBE_REP >> s) & 1)) reps = 2;
    }
    for (int rep = 0; rep < reps; ++rep) {
    if (ph > ph_lo || rep > 0) {
      if (ph == ph_lo + 1 && rep == 0) cg::this_grid().sync();
      else { ++nbar; grid_barrier(bar_ctr, nbar * gridDim.x); }
    }
    size_t z = 0;
    asm volatile("" : "+s"(z));
    const P& q = *(const P*)((const __attribute__((address_space(4))) char*)__builtin_amdgcn_kernarg_segment_ptr() + z);
    char* ldsq = lds + z;
    if (ph == 0) phase_prep(q, ldsq);
    else if (ph == NPH - 1) phase_final(q);
    else {
      const int l = (ph - 1) / 6, s = (ph - 1) % 6;
      if (s == 0) phase_norm(q, l);
      else if (s == 1) phase_gemm_in(q, l, ldsq);
      else if (s == 2) phase_mix1(q, l, ldsq);
      else if (s == 3) phase_scan(q, l, ldsq);
      else if (s == 4) phase_mix2(q, l, ldsq);
      else phase_gemm_out(q, l, ldsq);
    }
    }
  }
}

extern "C" void kernel_launch(void* const* d_in, const int* in_sizes, int n_in, void* d_out, int out_size,
                              void* d_ws, size_t ws_size, hipStream_t stream) {
  static int grid = 0;
  if (grid == 0) {
    if (n_in != 33 || ws_size < WS_END) {
      fprintf(stderr, "kernel_launch: unexpected n_in %d or ws_size %zu (< %zu)\n", n_in, ws_size, (size_t)WS_END);
      grid = -1;
      return;
    }
    int dev = 0, cus = 0;
    hipGetDevice(&dev);
    hipDeviceGetAttribute(&cus, hipDeviceAttributeMultiprocessorCount, dev);
    if (hipFuncSetAttribute((const void*)fwd_megakernel, hipFuncAttributeMaxDynamicSharedMemorySize, LDS_BYTES) != hipSuccess) {
      fprintf(stderr, "kernel_launch: hipFuncSetAttribute failed\n");
      grid = -1;
      return;
    }
    int per_cu = 0;
    hipOccupancyMaxActiveBlocksPerMultiprocessor(&per_cu, (const void*)fwd_megakernel, 512, LDS_BYTES);
    (void)hipGetLastError();
    if (per_cu < 1) fprintf(stderr, "kernel_launch: occupancy query says %d blocks per CU\n", per_cu);
    grid = cus > 0 ? cus : 256;
  }
  if (grid < 0) return;
  P p{};
  for (int i = 0; i < 33; ++i) p.in[i] = (const float*)d_in[i];
  p.out = (float*)d_out;
  p.ws = (char*)d_ws;
#if MK_COOP
  if (hipMemsetAsync((char*)d_ws + OFF_BAR, 0, 256, stream) != hipSuccess) { fprintf(stderr, "kernel_launch: memset of barrier words failed\n"); return; }
  p.ph_lo = 0; p.ph_hi = NPH;
  void* args[] = {&p};
  hipError_t e = hipLaunchCooperativeKernel((const void*)fwd_megakernel, dim3(grid), dim3(512), args, LDS_BYTES, stream);
  if (e != hipSuccess) fprintf(stderr, "cooperative launch failed: %s (grid %d)\n", hipGetErrorString(e), grid);
#else
  for (int ph = 0; ph < NPH; ++ph) {
    p.ph_lo = ph; p.ph_hi = ph + 1;
    hipLaunchKernelGGL(fwd_megakernel, dim3(grid), dim3(512), LDS_BYTES, stream, p);
  }
#endif
}
```
